# Optimizing an MI355X kernel written in HIP

```python
import math
import jax
import jax.numpy as jnp
from jax import lax
import numpy as np

D_MODEL = 1024
BATCH = 32
SEQ = 2048
DEPTH = 4

CTX_LEN = 256
GRID_W = 64
EPS = 1e-6
F32 = jnp.float32

BRANCH_WIDTH = 256
N_BRANCH = 4
S5_GROUP = 16
S5_GROUPS = BRANCH_WIDTH // S5_GROUP
S5_STATE = 64
FN_GROUPS = 4
FN_GROUP = BRANCH_WIDTH // FN_GROUPS
GDN_HEADS = 4
GDN_HEAD_DIM = BRANCH_WIDTH // GDN_HEADS
GDN_CHUNK = 64
GDN_CONV = 3
SG_GROUPS = 4
SG_GROUP = BRANCH_WIDTH // SG_GROUPS
SG_CHUNK = 128
D_FF = -(-8 * D_MODEL // (3 * 256)) * 256

IN_SIZES = (BRANCH_WIDTH, BRANCH_WIDTH, BRANCH_WIDTH, 2 * GDN_HEADS, 2 * GDN_HEADS,
            BRANCH_WIDTH, BRANCH_WIDTH, BRANCH_WIDTH, BRANCH_WIDTH, BRANCH_WIDTH,
            N_BRANCH * D_MODEL)
N_STATE_BLOCKS = 5
N_STATE_COLS = 3 * BRANCH_WIDTH + 4 * GDN_HEADS
D_IN = 8 * BRANCH_WIDTH + 4 * GDN_HEADS + N_BRANCH * D_MODEL

kernel_name = 'hybrid_s5_fnet_gdn_sgu_diffusion_trunk'


def _ident(t):
    return t


def _rev(t):
    return None if t is None else t[:, ::-1]


def _split(p, sizes):
    return jnp.split(p, np.cumsum(sizes)[:-1].tolist(), axis=-1)


def _rmsnorm(x, g):
    xf = x.astype(F32)
    y = xf * lax.rsqrt(jnp.mean(xf * xf, axis=-1, keepdims=True) + EPS)
    return (y * g.astype(F32)).astype(x.dtype)


def _l2norm(t):
    return t * lax.rsqrt(jnp.sum(t * t, axis=-1, keepdims=True) + EPS)


def _cplx(re, im):
    return lax.complex(re.astype(F32), im.astype(F32))


def _short_conv(x, w):
    ch, kw = w.shape
    return lax.conv_general_dilated(
        x, w.T[:, None, :].astype(x.dtype), window_strides=(1,),
        padding=[(kw // 2, kw // 2)], dimension_numbers=('NWC', 'WIO', 'NWC'),
        feature_group_count=ch)


def _lin_combine(e1, e2):
    a1, b1 = e1
    a2, b2 = e2
    return a1 * a2, a2 * b1 + b2


def _s5_scan(u, a_bar, b_bar, s0):
    bu = jnp.einsum('gpc,btgc->btgp', b_bar, u.astype(jnp.complex64))
    if s0 is not None:
        bu = bu.at[:, 0].add(a_bar * s0)
    _, s = lax.associative_scan(_lin_combine, (jnp.broadcast_to(a_bar, bu.shape), bu), axis=1)
    return s


def _s5_branch(u_l, u_c, lp, ctx_out):
    B = u_l.shape[0]
    ul = u_l.astype(F32).reshape(B, -1, S5_GROUPS, S5_GROUP)
    uc = u_c.astype(F32).reshape(B, -1, S5_GROUPS, S5_GROUP)
    s_lat, s_ctx = [], []
    for d in range(2):
        f = _rev if d else _ident
        lam = _cplx(lp['s5_lam_re'][d], lp['s5_lam_im'][d])
        a_bar = jnp.exp(lam * jnp.exp(lp['s5_log_dt'][d].astype(F32))[:, None])
        b_bar = ((a_bar - 1.0) / lam)[..., None] * _cplx(lp['s5_b_re'][d], lp['s5_b_im'][d])
        sc = _s5_scan(f(uc), a_bar, b_bar, None)
        sl = _s5_scan(f(ul), a_bar, b_bar, sc[:, -1])
        s_lat.append(f(sl))
        s_ctx.append(sc)
    c_f = _cplx(lp['s5_c_re'][0], lp['s5_c_im'][0])
    c_b = _cplx(lp['s5_c_re'][1], lp['s5_c_im'][1])
    d_skip = lp['s5_d'].astype(F32).reshape(S5_GROUPS, S5_GROUP)

    def readout(u, s_f, s_b):
        y = (jnp.einsum('gcp,btgp->btgc', c_f, s_f) + jnp.einsum('gcp,btgp->btgc', c_b, s_b)).real
        y = jax.nn.gelu((y + d_skip * u).reshape(B, -1, BRANCH_WIDTH))
        return y * jax.nn.sigmoid(y @ lp['s5_glu_w'].astype(F32) + lp['s5_glu_b'].astype(F32))

    y_l = readout(ul, s_lat[0], s_lat[1])
    y_c = readout(uc, s_ctx[0], _rev(s_ctx[1])) if ctx_out else None
    return y_l, y_c


def _fnet(u, w):
    B, L, _ = u.shape
    ug = u.astype(F32).reshape(B, L, FN_GROUPS, FN_GROUP).transpose(0, 2, 1, 3)
    f = jnp.fft.fft2(ug, norm='ortho').real
    return jnp.einsum('bglc,gce->blge', f, w.astype(F32)).reshape(B, L, BRANCH_WIDTH)


def _gdn_chunk(q, k, v, g, beta, s0, with_out):
    B, L, H, K = k.shape
    V = v.shape[-1]
    C = GDN_CHUNK
    N = L // C

    def blk(t):
        return jnp.moveaxis(t.reshape((B, N, C) + t.shape[2:]), 2, 3)

    k, v, beta = blk(k), blk(v), blk(beta)
    g = jnp.cumsum(blk(g), axis=-1)
    incl = jnp.tril(jnp.ones((C, C), dtype=bool))
    strict = jnp.tril(jnp.ones((C, C), dtype=bool), -1)
    rel = jnp.exp(jnp.where(incl, g[..., :, None] - g[..., None, :], -jnp.inf))
    kb = k * beta[..., None]
    a = jnp.where(strict, jnp.einsum('bnhik,bnhjk->bnhij', kb, k) * rel, 0.0)
    rhs = jnp.concatenate([v * beta[..., None], kb * jnp.exp(g)[..., None]], axis=-1)
    sol = lax.linalg.triangular_solve(a + jnp.eye(C, dtype=F32), rhs, left_side=True,
                                      lower=True, unit_diagonal=True)
    w_v, w_k = sol[..., :V], sol[..., V:]
    k_dec = k * jnp.exp(g[..., -1:] - g)[..., None]
    g_tot = jnp.exp(g[..., -1])

    def to_scan(t):
        return jnp.moveaxis(t, 1, 0)

    if with_out:
        q = blk(q)
        qk = jnp.where(incl, jnp.einsum('bnhik,bnhjk->bnhij', q, k) * rel, 0.0)
        q_dec = q * jnp.exp(g)[..., None]

        def step(s, xs):
            wv, wk, kd, gt, qkm, qd = xs
            u = wv - jnp.einsum('bhck,bhkv->bhcv', wk, s)
            o = jnp.einsum('bhck,bhkv->bhcv', qd, s) + jnp.einsum('bhij,bhjv->bhiv', qkm, u)
            return s * gt[..., None, None] + jnp.einsum('bhck,bhcv->bhkv', kd, u), o

        xs = (w_v, w_k, k_dec, g_tot, qk, q_dec)
        s_fin, o = lax.scan(step, s0, tuple(to_scan(t) for t in xs))
        o = jnp.moveaxis(jnp.moveaxis(o, 0, 1), 3, 2).reshape(B, L, H, V)
        return o, s_fin

    def step_state(s, xs):
        wv, wk, kd, gt = xs
        u = wv - jnp.einsum('bhck,bhkv->bhcv', wk, s)
        return s * gt[..., None, None] + jnp.einsum('bhck,bhcv->bhkv', kd, u), None

    xs = (w_v, w_k, k_dec, g_tot)
    s_fin, _ = lax.scan(step_state, s0, tuple(to_scan(t) for t in xs))
    return None, s_fin


def _gdn_prep(q, k, v, a, b, lp):
    conv = lp['gdn_conv']
    B, L, _ = k.shape

    def feats(t, w):
        return jax.nn.silu(_short_conv(t, w).astype(F32)).reshape(B, L, GDN_HEADS, GDN_HEAD_DIM)

    kk = _l2norm(feats(k, conv[0]))
    vv = feats(v, conv[1])
    qq = None if q is None else _l2norm(feats(q, conv[2])) * GDN_HEAD_DIM ** -0.5
    a = a.astype(F32).reshape(B, L, 2, GDN_HEADS)
    b = b.astype(F32).reshape(B, L, 2, GDN_HEADS)
    g = -jnp.exp(lp['gdn_a_log'].astype(F32)) * jax.nn.softplus(a + lp['gdn_dt_bias'].astype(F32))
    return qq, kk, vv, g, jax.nn.sigmoid(b)


def _gdn_out(o, z, gain):
    B, L = o.shape[:2]
    gate = jax.nn.silu(z.astype(F32)).reshape(B, L, GDN_HEADS, GDN_HEAD_DIM)
    return (_rmsnorm(o, gain) * gate).reshape(B, L, BRANCH_WIDTH)


def _gdn_branch(lat, ctx, z, zc, lp, ctx_out):
    ql, kl, vl, gl, bl = _gdn_prep(*lat, lp)
    qc, kc, vc, gc, bc = _gdn_prep(*ctx, lp)
    s0 = jnp.zeros((kl.shape[0], GDN_HEADS, GDN_HEAD_DIM, GDN_HEAD_DIM), F32)
    o_lat, o_ctx = [], []
    for d in range(2):
        f = _rev if d else _ident
        oc, sc = _gdn_chunk(f(qc), f(kc), f(vc), f(gc[:, :, d]), f(bc[:, :, d]), s0, ctx_out)
        ol, _ = _gdn_chunk(f(ql), f(kl), f(vl), f(gl[:, :, d]), f(bl[:, :, d]), sc, True)
        o_lat.append(f(ol))
        o_ctx.append(f(oc))
    y_l = _gdn_out(o_lat[0] + o_lat[1], z, lp['gdn_norm'])
    y_c = _gdn_out(o_ctx[0] + o_ctx[1], zc, lp['gdn_norm']) if ctx_out else None
    return y_l, y_c


def _sgu(u, v, lp, n_chunks):
    B, L, _ = u.shape
    shp = (B, n_chunks, SG_CHUNK, SG_GROUPS, SG_GROUP)
    u = jax.nn.gelu(u.astype(F32)).reshape(shp)
    v = jax.nn.gelu(v.astype(F32)).reshape(shp)
    mu = jnp.mean(v, axis=-1, keepdims=True)
    var = jnp.mean(jnp.square(v - mu), axis=-1, keepdims=True)
    v = ((v - mu) * lax.rsqrt(var + EPS) * lp['sg_ln_g'].astype(F32).reshape(SG_GROUPS, SG_GROUP)
         + lp['sg_ln_b'].astype(F32).reshape(SG_GROUPS, SG_GROUP))
    sv = jnp.einsum('gpq,bnqgc->bnpgc', lp['sg_w'].astype(F32), v) + lp['sg_b'].astype(F32).T[:, :, None]
    return (u * sv).reshape(B, L, BRANCH_WIDTH)


def _merge(ys, gate, w_branch, w_out):
    B, L, _ = gate.shape
    g = jax.nn.sigmoid(gate.astype(F32)).reshape(B, L, N_BRANCH, D_MODEL)
    acc = g[:, :, 0] * (ys[0] @ w_branch[0])
    for i in range(1, N_BRANCH):
        acc = acc + g[:, :, i] * (ys[i] @ w_branch[i])
    return acc @ w_out


def _mixer(h, hc, lp, rows, ctx_out):
    u5, k, v, a, b, q, z, ufn, usg, vsg, gate = _split(h @ lp['w_in'], IN_SIZES)
    if ctx_out:
        u5c, kc, vc, ac, bc, qc, zc, ufnc, usgc, vsgc, gatec = _split(hc @ lp['w_in'], IN_SIZES)
    else:
        u5c, kc, vc, ac, bc = _split(hc @ lp['w_in'][:, :N_STATE_COLS], IN_SIZES[:N_STATE_BLOCKS])
        qc = zc = None
    y5, y5c = _s5_branch(u5, u5c, lp, ctx_out)
    yg, ygc = _gdn_branch((q, k, v, a, b), (qc, kc, vc, ac, bc), z, zc, lp, ctx_out)
    yfn = _fnet(ufn, lp['fn_w'])
    ysg = _sgu(usg, vsg, lp, rows * GRID_W // SG_CHUNK)
    out = _merge((y5, yfn, yg, ysg), gate, lp['w_branch'], lp['w_out']).astype(h.dtype)
    if not ctx_out:
        return out, None
    yfnc = _fnet(ufnc, lp['fn_w'])
    ysgc = _sgu(usgc, vsgc, lp, hc.shape[1] // SG_CHUNK)
    outc = _merge((y5c, yfnc, ygc, ysgc), gatec, lp['w_branch'], lp['w_out']).astype(hc.dtype)
    return out, outc


def _swiglu(h, w1, w2):
    gt, up = jnp.split(h @ w1, 2, axis=-1)
    return (jax.nn.silu(gt) * up) @ w2


def setup_inputs(seed: int = 0) -> dict:
    key = jax.random.key(seed)
    ks = iter(jax.random.split(key, 48))

    def nrm(shape, scale):
        return jax.random.normal(next(ks), shape, F32) * scale

    Lr, D, W = DEPTH, D_MODEL, BRANCH_WIDTH
    G, P, H = S5_GROUPS, S5_STATE, GDN_HEADS
    n = jnp.arange(P, dtype=F32)
    gdn_dt = jnp.exp(jax.random.uniform(next(ks), (Lr, 2, H), F32, math.log(1e-3), math.log(1e-1)))
    return {
        'x': nrm((BATCH, SEQ, D), 1.0),
        'c': nrm((BATCH, D), 1.0),
        'ctx': nrm((BATCH, CTX_LEN, D), 1.0),
        'c_ctx': nrm((D,), 1.0),
        'ada_w': nrm((Lr, D, 6 * D), 0.5 * D ** -0.5),
        'ada_b': nrm((Lr, 6 * D), 0.02),
        'norm1': 1.0 + nrm((Lr, D), 0.02),
        'norm2': 1.0 + nrm((Lr, D), 0.02),
        'w_in': nrm((Lr, D, D_IN), D ** -0.5),
        's5_lam_re': -0.5 + nrm((Lr, 2, G, P), 0.01),
        's5_lam_im': jnp.pi * n + nrm((Lr, 2, G, P), 0.01),
        's5_log_dt': jax.random.uniform(next(ks), (Lr, 2, G), F32, math.log(1e-3), math.log(1e-1)),
        's5_b_re': nrm((Lr, 2, G, P, S5_GROUP), (2 * S5_GROUP) ** -0.5),
        's5_b_im': nrm((Lr, 2, G, P, S5_GROUP), (2 * S5_GROUP) ** -0.5),
        's5_c_re': nrm((Lr, 2, G, S5_GROUP, P), 0.5 ** 0.5),
        's5_c_im': nrm((Lr, 2, G, S5_GROUP, P), 0.5 ** 0.5),
        's5_d': nrm((Lr, W), 0.5),
        's5_glu_w': nrm((Lr, W, W), W ** -0.5),
        's5_glu_b': nrm((Lr, W), 0.02),
        'fn_w': nrm((Lr, FN_GROUPS, FN_GROUP, FN_GROUP), FN_GROUP ** -0.5),
        'gdn_conv': nrm((Lr, 3, W, GDN_CONV), GDN_CONV ** -0.5),
        'gdn_a_log': jnp.log(jax.random.uniform(next(ks), (Lr, 2, H), F32, 1.0, 16.0)),
        'gdn_dt_bias': gdn_dt + jnp.log(-jnp.expm1(-gdn_dt)),
        'gdn_norm': 1.0 + nrm((Lr, GDN_HEAD_DIM), 0.02),
        'sg_ln_g': 1.0 + nrm((Lr, W), 0.02),
        'sg_ln_b': nrm((Lr, W), 0.02),
        'sg_w': nrm((Lr, SG_GROUPS, SG_CHUNK, SG_CHUNK), SG_CHUNK ** -0.5),
        'sg_b': 1.0 + nrm((Lr, SG_GROUPS, SG_CHUNK), 0.02),
        'w_branch': nrm((Lr, N_BRANCH, W, D), W ** -0.5),
        'w_out': nrm((Lr, D, D), D ** -0.5),
        'ffn_w1': nrm((Lr, D, 2 * D_FF), D ** -0.5),
        'ffn_w2': nrm((Lr, D_FF, D), D_FF ** -0.5),
        'norm_f': 1.0 + nrm((D,), 0.02),
    }


def reference(x, c, ctx, c_ctx, ada_w, ada_b, norm1, norm2, w_in, s5_lam_re, s5_lam_im,
              s5_log_dt, s5_b_re, s5_b_im, s5_c_re, s5_c_im, s5_d, s5_glu_w, s5_glu_b, fn_w,
              gdn_conv, gdn_a_log, gdn_dt_bias, gdn_norm, sg_ln_g, sg_ln_b, sg_w, sg_b,
              w_branch, w_out, ffn_w1, ffn_w2, norm_f):
    rows = x.shape[1] // GRID_W
    xc = ctx
    silu_c = jax.nn.silu(c)[:, None, :]
    silu_cc = jax.nn.silu(c_ctx)
    for l in range(DEPTH):
        ctx_out = l < DEPTH - 1
        lp = {
            'w_in': w_in[l], 's5_lam_re': s5_lam_re[l], 's5_lam_im': s5_lam_im[l],
            's5_log_dt': s5_log_dt[l], 's5_b_re': s5_b_re[l], 's5_b_im': s5_b_im[l],
            's5_c_re': s5_c_re[l], 's5_c_im': s5_c_im[l], 's5_d': s5_d[l],
            's5_glu_w': s5_glu_w[l], 's5_glu_b': s5_glu_b[l], 'fn_w': fn_w[l],
            'gdn_conv': gdn_conv[l], 'gdn_a_log': gdn_a_log[l], 'gdn_dt_bias': gdn_dt_bias[l],
            'gdn_norm': gdn_norm[l], 'sg_ln_g': sg_ln_g[l], 'sg_ln_b': sg_ln_b[l],
            'sg_w': sg_w[l], 'sg_b': sg_b[l], 'w_branch': w_branch[l], 'w_out': w_out[l],
        }
        sh1, sc1, g1, sh2, sc2, g2 = jnp.split(silu_c @ ada_w[l] + ada_b[l], 6, axis=-1)
        csh1, csc1, cg1, csh2, csc2, cg2 = jnp.split(silu_cc @ ada_w[l] + ada_b[l], 6, axis=-1)
        h = _rmsnorm(x, norm1[l]) * (1.0 + sc1) + sh1
        hc = _rmsnorm(xc, norm1[l]) * (1.0 + csc1) + csh1
        y, yc = _mixer(h, hc, lp, rows, ctx_out)
        x = x + g1 * y
        x = x + g2 * _swiglu(_rmsnorm(x, norm2[l]) * (1.0 + sc2) + sh2, ffn_w1[l], ffn_w2[l])
        if ctx_out:
            xc = xc + cg1 * yc
            xc = xc + cg2 * _swiglu(_rmsnorm(xc, norm2[l]) * (1.0 + csc2) + csh2, ffn_w1[l], ffn_w2[l])
    return _rmsnorm(x, norm_f)
```

```cpp
#include <hip/hip_runtime.h>
#include <hip/hip_cooperative_groups.h>
#include <cstdio>
namespace cg = cooperative_groups;

typedef unsigned short u16;
using bf16x8 = __attribute__((ext_vector_type(8))) short;
using f32x4 = __attribute__((ext_vector_type(4))) float;

#define NT 512
#define NW 8

constexpr int BATCH = 32, SEQ = 2048, CTXL = 256, DM = 1024, DEPTH = 4;
constexpr int ML = BATCH * SEQ;
constexpr int MC = BATCH * CTXL;
constexpr int MT = ML + MC;
constexpr int DIN = 6160, DFF = 2816;
constexpr int NPROJ = 2304;
constexpr int PBW = 1792;
constexpr int PB_K = 256, PB_V = 512, PB_Q = 768, PB_Z = 1024, PB_USG = 1280, PB_VSG = 1536;
constexpr float EPS = 1e-6f;

constexpr size_t WIN_OFF = 0;
constexpr size_t WG_OFF = WIN_OFF + (size_t)NPROJ * 1024;
constexpr size_t WB_OFF = WG_OFF + (size_t)4096 * 1024;
constexpr size_t WO_OFF = WB_OFF + (size_t)1024 * 1024;
constexpr size_t W1_OFF = WO_OFF + (size_t)1024 * 1024;
constexpr size_t W2_OFF = W1_OFF + (size_t)5632 * 1024;
constexpr size_t GLU_OFF = W2_OFF + (size_t)1024 * DFF;
constexpr size_t LAYER_W = GLU_OFF + 65536;

constexpr size_t al256(size_t x) { return (x + 255) & ~(size_t)255; }
constexpr size_t OFF_W = 0;
constexpr size_t OFF_SGW = al256(OFF_W + 4 * LAYER_W * 2);
constexpr size_t OFF_DL = al256(OFF_SGW + (size_t)4 * 4 * 128 * 128 * 2);
constexpr size_t OFF_DC = al256(OFF_DL + (size_t)2048 * 4096 * 2);
constexpr size_t OFF_MOD = al256(OFF_DC + (size_t)256 * 512 * 2);
constexpr size_t OFF_CNT = al256(OFF_MOD + (size_t)4 * 33 * 6144 * 4);
constexpr size_t OFF_BAR = al256(OFF_CNT + 256);
constexpr size_t OFF_XC = al256(OFF_BAR + 3456 * 4);
constexpr size_t OFF_H = al256(OFF_XC + (size_t)MC * 1024 * 4);
constexpr size_t OFF_PB = al256(OFF_H + (size_t)MT * 1024 * 2);
constexpr size_t OFF_FT = al256(OFF_PB + (size_t)MT * PBW * 2);
constexpr size_t OFF_FTC = al256(OFF_FT + (size_t)32 * 256 * 4096 * 2);
constexpr size_t OFF_AB = al256(OFF_FTC + (size_t)32 * 256 * 512 * 2);
constexpr size_t OFF_O5F = al256(OFF_AB + (size_t)MT * 16 * 4);
constexpr size_t OFF_O5B = al256(OFF_O5F + (size_t)MT * 256 * 2);
constexpr size_t OFF_OGF = al256(OFF_O5B + (size_t)MT * 256 * 2);
constexpr size_t OFF_OGB = al256(OFF_OGF + (size_t)MT * 256 * 2);
constexpr size_t OFF_Y = al256(OFF_OGB + (size_t)MT * 256 * 2);
constexpr size_t WS_END = al256(OFF_Y + (size_t)MT * 1024 * 2);
constexpr size_t OFF_ACC = OFF_PB;
constexpr size_t OFF_BRS = al256(OFF_PB + (size_t)MT * 1024 * 2);
static_assert(OFF_BRS + (size_t)256 * 524288 <= OFF_AB, "BRS alias too small");
constexpr size_t OFF_HID = OFF_PB;
static_assert(OFF_HID + (size_t)MT * DFF * 2 <= WS_END, "HID alias too small");

constexpr int STAGE_BYTES = 131072;
constexpr int SMALL_OFF = 152064;
constexpr int DSM_BYTES = SMALL_OFF + 256;

struct Params {
  const float* in[33];
  float* out;
  char* ws;
};

typedef __bf16 bf16x2_t __attribute__((ext_vector_type(2)));
__device__ __forceinline__ unsigned pack2(float a, float b) { bf16x2_t v = {(__bf16)a, (__bf16)b}; return __builtin_bit_cast(unsigned, v); }
__device__ __forceinline__ u16 f2bf(float f) { return __builtin_bit_cast(u16, (__bf16)f); }
__device__ __forceinline__ float bf2f(u16 h) { return __uint_as_float(((unsigned)h) << 16); }
__device__ __forceinline__ float lo2f(unsigned w) { return __uint_as_float(w << 16); }
__device__ __forceinline__ float hi2f(unsigned w) { return __uint_as_float(w & 0xffff0000u); }
__device__ __forceinline__ float sigm(float x) { return __builtin_amdgcn_rcpf(1.f + __expf(-x)); }
__device__ __forceinline__ float silu_f(float x) { return x * sigm(x); }
__device__ __forceinline__ float gelu_t(float x) { return x * sigm(1.5957691216057308f * (x + 0.044715f * x * x * x)); }
__device__ __forceinline__ float softplus_f(float x) { return x > 20.f ? x : log1pf(__expf(x)); }

__device__ __forceinline__ int tid_l() { int t = threadIdx.x; asm volatile("" : "+v"(t)); return t; }
#define WAVE_SYNC() do { __builtin_amdgcn_fence(__ATOMIC_SEQ_CST, "wavefront"); __builtin_amdgcn_wave_barrier(); } while (0)

#define XB_TMO      128
#define XB_XCNT(j)  (256  + 64 * (j))
#define XB_XSUB(j)  (1280 + 64 * (j))
#define XB_XGEN(j)  (2304 + 64 * (j))
#define XB_TOP      3328
#define XB_TOPGEN   3392
#define XCD_BAR_WORDS 3456
#define XB_SPIN_CAP (1u << 18)
__device__ __forceinline__ unsigned xb_ld(unsigned* p)              { return __hip_atomic_load(p, __ATOMIC_RELAXED, __HIP_MEMORY_SCOPE_AGENT); }
__device__ __forceinline__ unsigned xb_add(unsigned* p, unsigned v) { return __hip_atomic_fetch_add(p, v, __ATOMIC_RELAXED, __HIP_MEMORY_SCOPE_AGENT); }
__device__ __forceinline__ unsigned xb_xcc_id() { return (unsigned)__builtin_amdgcn_s_getreg((3 << 11) | 20) & 0xFu; }
#define XB_SPIN(cond, bar) do { unsigned _sp = 0; while (cond) { __builtin_amdgcn_s_sleep(1); \
    if ((++_sp & 255u) == 0u) { if (xb_ld(&(bar)[XB_TMO])) break; if (_sp > XB_SPIN_CAP) { atomicAdd(&(bar)[XB_TMO], 1u); break; } } } } while (0)
struct XcdBarrier { unsigned* bar; unsigned x; volatile __attribute__((address_space(3))) unsigned* st; };
__device__ __forceinline__ XcdBarrier xcd_barrier_post(unsigned* bar, volatile __attribute__((address_space(3))) unsigned* st) {
  XcdBarrier b; b.bar = bar; b.x = xb_xcc_id(); b.st = st;
  if (threadIdx.x == 0) (void)xb_add(&bar[XB_XCNT(b.x)], 1u);
  return b;
}
__device__ __forceinline__ void xcd_barrier_complete(unsigned* bar, unsigned x, unsigned& nloc, unsigned& nx) {
  const unsigned G = gridDim.x * gridDim.y * gridDim.z;
  unsigned sum, cnt, mine, sp = 0u;
  for (;;) {
    sum = 0u; cnt = 0u; mine = 0u;
#pragma unroll
    for (unsigned j = 0; j < 16; ++j) { const unsigned c = xb_ld(&bar[XB_XCNT(j)]); sum += c; cnt += (c > 0u) ? 1u : 0u; mine = (j == x) ? c : mine; }
    if (sum == G) break;
    __builtin_amdgcn_s_sleep(1);
    if ((++sp & 255u) == 0u) { if (xb_ld(&bar[XB_TMO])) break; if (sp > XB_SPIN_CAP) { atomicAdd(&bar[XB_TMO], 1u); break; } }
  }
  nloc = mine > 0u ? mine : 1u; nx = cnt > 0u ? cnt : 1u;
}
__device__ __forceinline__ void xcd_barrier(const XcdBarrier& b0) {
  asm volatile("s_waitcnt vmcnt(0)" ::: "memory");
  __syncthreads();
  if (threadIdx.x == 0) {
    XcdBarrier b = b0;
    { unsigned xs = xb_xcc_id(); asm volatile("" : "+s"(xs)); b.x = xs; }
    unsigned* bar = b.bar;
    __builtin_amdgcn_s_waitcnt(0);
    unsigned nloc = b.st[0], nx = b.st[1];
    if (nloc == 0u) { xcd_barrier_complete(bar, b.x, nloc, nx); b.st[0] = nloc; b.st[1] = nx; }
    const unsigned old = xb_add(&bar[XB_XSUB(b.x)], 1u);
    const unsigned gen = old / nloc;
    if (old + 1u == (gen + 1u) * nloc) {
      __builtin_amdgcn_fence(__ATOMIC_RELEASE, "agent");
      asm volatile("s_waitcnt vmcnt(0)" ::: "memory");
      const unsigned og = xb_add(&bar[XB_TOP], 1u);
      const unsigned tg = og / nx;
      if (og + 1u == (tg + 1u) * nx) xb_add(&bar[XB_TOPGEN], 1u);
      else XB_SPIN(xb_ld(&bar[XB_TOPGEN]) == tg, bar);
      __builtin_amdgcn_fence(__ATOMIC_ACQUIRE, "agent");
      xb_add(&bar[XB_XGEN(b.x)], 1u);
      asm volatile("s_waitcnt vmcnt(0)" ::: "memory");
    } else {
      XB_SPIN(xb_ld(&bar[XB_XGEN(b.x)]) == gen, bar);
      __builtin_amdgcn_fence(__ATOMIC_ACQUIRE, "agent");
      asm volatile("s_waitcnt vmcnt(0)" ::: "memory");
    }
  }
  __syncthreads();
}

template <int CTRL>
__device__ __forceinline__ float dpp_f(float x) {
  return __int_as_float(__builtin_amdgcn_update_dpp(0, __float_as_int(x), CTRL, 0xF, 0xF, true));
}
__device__ __forceinline__ float reduce4(float x) {
  x += dpp_f<0xB1>(x);
  x += dpp_f<0x4E>(x);
  return x;
}
__device__ __forceinline__ float reduce16(float x) {
  x += dpp_f<0xB1>(x);
  x += dpp_f<0x4E>(x);
  x += dpp_f<0x141>(x);
  x += dpp_f<0x140>(x);
  return x;
}
__device__ __forceinline__ float reduce8(float x) {
  x += dpp_f<0xB1>(x);
  x += dpp_f<0x4E>(x);
  x += dpp_f<0x141>(x);
  return x;
}
__device__ __forceinline__ bool tile_map(int t, int nM, int nN, int& mt, int& nt) {
  const int total = nM * nN;
  const int chunk = (total + 7) >> 3;
  const int q = (t & 7) * chunk + (t >> 3);
  if ((t >> 3) >= chunk || q >= total) return false;
  const int per = 8 * nN;
  const int grp = q / per, r = q - grp * per;
  mt = grp * 8 + (r & 7);
  nt = r >> 3;
  return true;
}
__device__ __forceinline__ int tile_iters(int nM, int nN) { return 8 * ((nM * nN + 7) >> 3); }

template <int NB>
__device__ __forceinline__ void gemm_tile(const u16* __restrict__ A, long lda, const u16* __restrict__ B, long ldb,
                                          int K, f32x4 (&acc)[4][NB], char* smem) {
  const int tid = tid_l() & 255, lane = tid & 63, wid = tid >> 6, wr = wid >> 1, wc = wid & 1, fr = lane & 15, fq = lane >> 4;
  const int nt = K >> 5;
  __syncthreads();
  auto stage = [&](int kt, int buf) {
#pragma unroll
    for (int i = 0; i < 2; ++i) {
      const int bo = tid * 16 + i * 4096;
      const int r = bo >> 6, c = (bo & 63) >> 1;
      __builtin_amdgcn_global_load_lds((const unsigned*)(A + (long)r * lda + kt * 32 + c),
                                       (unsigned*)(smem + buf * 16384 + bo), 16, 0, 0);
      if (i < NB / 2)
        __builtin_amdgcn_global_load_lds((const unsigned*)(B + (long)r * ldb + kt * 32 + c),
                                         (unsigned*)(smem + buf * 16384 + 8192 + bo), 16, 0, 0);
    }
  };
  stage(0, 0);
#pragma unroll 1
  for (int t = 0; t < nt; ++t) {
    asm volatile("s_waitcnt vmcnt(0)" ::: "memory");
    __syncthreads();
    if (t + 1 < nt) stage(t + 1, (t + 1) & 1);
    const char* sa = smem + (t & 1) * 16384;
    const char* sb = sa + 8192;
    bf16x8 a[4], b[NB];
#pragma unroll
    for (int m = 0; m < 4; ++m) a[m] = *reinterpret_cast<const bf16x8*>(sa + (wr * 64 + m * 16 + fr) * 64 + fq * 16);
#pragma unroll
    for (int n = 0; n < NB; ++n) b[n] = *reinterpret_cast<const bf16x8*>(sb + (wc * (NB * 16) + n * 16 + fr) * 64 + fq * 16);
    asm volatile("s_waitcnt lgkmcnt(0)" ::: "memory");
    __builtin_amdgcn_sched_barrier(0);
#pragma unroll
    for (int m = 0; m < 4; ++m)
#pragma unroll
      for (int n = 0; n < NB; ++n)
        acc[m][n] = __builtin_amdgcn_mfma_f32_16x16x32_bf16(a[m], b[n], acc[m][n], 0, 0, 0);
  }
}

template <int NB>
__device__ __forceinline__ void zero_acc(f32x4 (&acc)[4][NB]) {
#pragma unroll
  for (int m = 0; m < 4; ++m)
#pragma unroll
    for (int n = 0; n < NB; ++n) acc[m][n] = f32x4{0.f, 0.f, 0.f, 0.f};
}

#define PG8_LAS __attribute__((address_space(3)))
constexpr int G_BK = 64, G_HALF = 128, G_HTB = G_HALF * G_BK * 2, G_NXCD = 8, G_WGM = 8;
__device__ __forceinline__ int lds_byte(int r, int c) { const int st = (r >> 4) * 2 + (c >> 5), rr = r & 15, cc = c & 31, ob = rr * 64 + cc * 2; return st * 1024 + (ob ^ (((ob >> 9) & 1) << 5)); }
__device__ __forceinline__ void stage_rc(int b, int& R, int& C) { const int st = b / 1024, sb = b % 1024, swz = sb ^ (((sb >> 9) & 1) << 5); R = (st >> 1) * 16 + swz / 64; C = (st & 1) * 32 + (swz % 64) / 2; }
struct Unit { int pm, pn; };

struct SchedStd {
  int nM, nN, nwg, G, c, ktiles;
  const char* A; const char* B; size_t tA, tB;
  __device__ __forceinline__ void init(int nM_, int nN_, int K_, const void* A_, size_t tA_, const void* B_, size_t tB_) {
    nM = nM_; nN = nN_; nwg = nM * nN; G = gridDim.x; c = blockIdx.x; ktiles = K_ / G_BK; A = (const char*)A_; B = (const char*)B_; tA = tA_; tB = tB_;
  }
  __device__ __forceinline__ int kt(const Unit&) const { return ktiles; }
  __device__ __forceinline__ bool next(int i, Unit& u) const {
    const long L = (long)i * G + c;
    if (L >= nwg) return false;
    int wgid = (int)L;
    { const int q = nwg / G_NXCD, r = nwg % G_NXCD, xcd = wgid % G_NXCD, off = wgid / G_NXCD; wgid = (xcd < r ? xcd * (q + 1) : r * (q + 1) + (xcd - r) * q) + off; }
    const int nig = G_WGM * nN, gid = wgid / nig, fm = gid * G_WGM, gsz = (nM - fm) < G_WGM ? (nM - fm) : G_WGM;
    u.pm = fm + ((wgid % nig) % gsz); u.pn = (wgid % nig) / gsz;
    return true;
  }
  __device__ __forceinline__ const char* aptr(const Unit& u) const { return A + (size_t)u.pm * tA; }
  __device__ __forceinline__ const char* bptr(const Unit& u) const { return B + (size_t)u.pn * tB; }
};
struct SchedProjLast {
  SchedStd s;
  __device__ __forceinline__ bool next(int i, Unit& u) const {
    if (s.next(i, u)) return true;
    const long L = (long)i * s.G + s.c - s.nwg;
    if (L < 0 || L >= 128) return false;
    const int k = (int)L & 3;
    u.pm = 256 + ((int)L >> 2); u.pn = (k == 3) ? 7 : k;
    return true;
  }
  __device__ __forceinline__ const char* aptr(const Unit& u) const { return s.aptr(u); }
  __device__ __forceinline__ const char* bptr(const Unit& u) const { return s.bptr(u); }
  __device__ __forceinline__ int kt(const Unit&) const { return s.ktiles; }
};
struct SchedOne {
  Unit u0; const char* A; const char* B; int ktiles;
  __device__ __forceinline__ int kt(const Unit&) const { return ktiles; }
  __device__ __forceinline__ bool next(int i, Unit& u) const { if (i) return false; u = u0; return true; }
  __device__ __forceinline__ const char* aptr(const Unit&) const { return A; }
  __device__ __forceinline__ const char* bptr(const Unit&) const { return B; }
};

template <class Epi, class Sched>
__device__ __forceinline__ void gemm_phase(PG8_LAS unsigned char* lds, const int lda, const int ldb, const Sched& S, const Epi& E) {
  const int tid = tid_l(), wid = __builtin_amdgcn_readfirstlane(tid >> 6), lane = tid & 63, wr = wid >> 2, wc = wid & 3, fr = lane & 15, fq = lane >> 4;
  unsigned voffA[2], voffB[2];
#pragma unroll
  for (int i = 0; i < 2; ++i) { int R, C; stage_rc(tid * 16 + i * 8192, R, C); voffA[i] = (unsigned)(R * lda + C) * 2u; voffB[i] = (unsigned)(R * ldb + C) * 2u; }
  const size_t kstep = (size_t)(G_BK * 2);
  const size_t hstepA = (size_t)G_HALF * lda * 2, hstepB = (size_t)G_HALF * ldb * 2;
  const unsigned ldsw = (unsigned)wid * 1024u;
  const int aoff = lds_byte(wr * 64 + fr, fq * 8), boff = lds_byte(wc * 32 + fr, fq * 8);
#define PG8_SA(b, h) (((b) * 2 + (h)) * G_HTB)
#define PG8_SB(b, h) ((4 + (b) * 2 + (h)) * G_HTB)
#define PG8_STAGE(bufoff, gbase, voff) do { _Pragma("unroll") for (int _i = 0; _i < 2; ++_i) \
    __builtin_amdgcn_global_load_lds((const unsigned*)((const char*)(gbase) + (voff)[_i]), (PG8_LAS unsigned*)(lds + (bufoff) + ldsw + _i * 8192), 16, 0, 0); } while (0)
#define PG8_LDA(dst, b, h) do { _Pragma("unroll") for (int m = 0; m < 4; ++m) _Pragma("unroll") for (int k = 0; k < 2; ++k) dst[m][k] = *(const PG8_LAS bf16x8*)(lds + PG8_SA(b, h) + aoff + m * 2048 + k * 1024); } while (0)
#define PG8_LDB(dst, b, h) do { _Pragma("unroll") for (int n = 0; n < 2; ++n) _Pragma("unroll") for (int k = 0; k < 2; ++k) dst[n][k] = *(const PG8_LAS bf16x8*)(lds + PG8_SB(b, h) + boff + n * 2048 + k * 1024); } while (0)
#define PG8_MMA(ai, bj, At, Bt) do { __builtin_amdgcn_s_setprio(1); _Pragma("unroll") for (int m = 0; m < 4; ++m) _Pragma("unroll") for (int n = 0; n < 2; ++n) _Pragma("unroll") for (int k = 0; k < 2; ++k) \
    acc[ai][bj][m][n] = __builtin_amdgcn_mfma_f32_16x16x32_bf16(Bt[n][k], At[m][k], acc[ai][bj][m][n], 0, 0, 0); __builtin_amdgcn_s_setprio(0); } while (0)
#define PG8_WAIT_V(n) asm volatile("s_waitcnt vmcnt(" #n ")" ::: "memory")
#define PG8_WAIT_L(n) asm volatile("s_waitcnt lgkmcnt(" #n ")" ::: "memory")
#define PG8_BAR __builtin_amdgcn_s_barrier()
#define PG8_SCHED __builtin_amdgcn_sched_barrier(0)
  Unit cur, nxt; int ui = 0;
  if (!S.next(0, cur)) return;
  int nt = S.kt(cur);
  f32x4 acc[2][2][4][2];
#pragma unroll
  for (int a = 0; a < 2; ++a)
#pragma unroll
    for (int b = 0; b < 2; ++b)
#pragma unroll
      for (int m = 0; m < 4; ++m)
#pragma unroll
        for (int n = 0; n < 2; ++n) acc[a][b][m][n] = (f32x4){0.f, 0.f, 0.f, 0.f};
  bf16x8 At[4][2], B0[2][2], B1[2][2];
  const char* cA = S.aptr(cur); const char* cB = S.bptr(cur);
  PG8_STAGE(PG8_SB(0, 0), cB, voffB); PG8_STAGE(PG8_SA(0, 0), cA, voffA); PG8_STAGE(PG8_SB(0, 1), cB + hstepB, voffB); PG8_STAGE(PG8_SA(0, 1), cA + hstepA, voffA);
  if (wr == 1) PG8_BAR;
  PG8_WAIT_V(4); PG8_BAR;
  PG8_STAGE(PG8_SB(1, 0), cB + kstep, voffB); PG8_STAGE(PG8_SA(1, 0), cA + kstep, voffA); PG8_STAGE(PG8_SB(1, 1), cB + hstepB + kstep, voffB);
  PG8_WAIT_V(6); PG8_BAR;
  for (;;) {
    const bool has_next = S.next(ui + 1, nxt);
    const char* nA = has_next ? S.aptr(nxt) : cA; const char* nB = has_next ? S.bptr(nxt) : cB;
#pragma unroll 1
    for (int t = 0; t < nt; t += 2) {
      const bool last = (t == nt - 2);
      const char* a1 = cA + (size_t)(t + 1) * kstep;
      const char* a2 = last ? nA : cA + (size_t)(t + 2) * kstep; const char* b2 = last ? nB : cB + (size_t)(t + 2) * kstep;
      const char* a3 = a2 + kstep; const char* b3 = b2 + kstep;
      PG8_LDB(B0, 0, 0); PG8_SCHED; PG8_LDA(At, 0, 0); PG8_STAGE(PG8_SA(1, 1), a1 + hstepA, voffA);
      PG8_WAIT_L(8); PG8_BAR; PG8_WAIT_L(0); PG8_MMA(0, 0, At, B0); PG8_BAR; PG8_SCHED;
      PG8_LDB(B1, 0, 1); PG8_STAGE(PG8_SB(0, 0), b2, voffB);
      PG8_BAR; PG8_WAIT_L(0); PG8_MMA(0, 1, At, B1); PG8_BAR;
      PG8_LDA(At, 0, 1); PG8_STAGE(PG8_SA(0, 0), a2, voffA);
      PG8_BAR; PG8_WAIT_L(0); PG8_MMA(1, 0, At, B0); PG8_BAR; PG8_SCHED;
      PG8_STAGE(PG8_SB(0, 1), b2 + hstepB, voffB);
      PG8_WAIT_V(6); PG8_BAR; PG8_MMA(1, 1, At, B1); PG8_BAR;
      PG8_LDB(B0, 1, 0); PG8_SCHED; PG8_LDA(At, 1, 0); PG8_STAGE(PG8_SA(0, 1), a2 + hstepA, voffA);
      PG8_WAIT_L(8); PG8_BAR; PG8_WAIT_L(0); PG8_MMA(0, 0, At, B0); PG8_BAR; PG8_SCHED;
      PG8_LDB(B1, 1, 1); PG8_STAGE(PG8_SB(1, 0), b3, voffB);
      PG8_BAR; PG8_WAIT_L(0); PG8_MMA(0, 1, At, B1); PG8_BAR;
      PG8_LDA(At, 1, 1); PG8_STAGE(PG8_SA(1, 0), a3, voffA);
      PG8_BAR; PG8_WAIT_L(0); PG8_MMA(1, 0, At, B0); PG8_BAR; PG8_SCHED;
      PG8_STAGE(PG8_SB(1, 1), b3 + hstepB, voffB);
      PG8_WAIT_V(6); PG8_BAR; PG8_MMA(1, 1, At, B1); PG8_BAR;
    }
    E(acc, cur, wr, wc, fr, fq);
    if (!has_next) break;
#pragma unroll
    for (int a = 0; a < 2; ++a)
#pragma unroll
      for (int b = 0; b < 2; ++b)
#pragma unroll
        for (int m = 0; m < 4; ++m)
#pragma unroll
          for (int n = 0; n < 2; ++n) acc[a][b][m][n] = (f32x4){0.f, 0.f, 0.f, 0.f};
    cur = nxt; cA = nA; cB = nB; ++ui;
    nt = S.kt(cur);
  }
  PG8_WAIT_V(0);
  if (wr == 0) PG8_BAR;
  PG8_BAR;
#undef PG8_SA
#undef PG8_SB
#undef PG8_STAGE
#undef PG8_LDA
#undef PG8_LDB
#undef PG8_MMA
#undef PG8_WAIT_V
#undef PG8_WAIT_L
#undef PG8_BAR
#undef PG8_SCHED
}

struct EpiProj {
  u16* PB; u16* FT; u16* FTC; float* AB;
  __device__ __forceinline__ void operator()(const f32x4 (&acc)[2][2][4][2], const Unit& u, int wr, int wc, int fr, int fq) const {
#pragma unroll
    for (int ai = 0; ai < 2; ++ai)
#pragma unroll
      for (int m = 0; m < 4; ++m) {
        const int r = u.pm * 256 + ai * 128 + wr * 64 + m * 16 + fr;
#pragma unroll
        for (int bj = 0; bj < 2; ++bj)
#pragma unroll
          for (int n = 0; n < 2; ++n) {
            const f32x4 v = acc[ai][bj][m][n];
            const int c = u.pn * 256 + bj * 128 + wc * 32 + n * 16 + 4 * fq;
            if (u.pn < 7) {
              uint2 w; w.x = pack2(v[0], v[1]); w.y = pack2(v[2], v[3]);
              *reinterpret_cast<uint2*>(PB + (size_t)r * PBW + c) = w;
            } else {
              const int nn = c - 1792, part = nn >> 8, ch = nn & 255;
              if (u.pn == 7 && bj == 0 && wc == 1 && n == 1) {
                *reinterpret_cast<float4*>(AB + (size_t)r * 16 + 4 * fq) = make_float4(v[0], v[1], v[2], v[3]);
              } else {
                u16* d; int cstride;
                if (r < ML) { const int b = r >> 11, tt = r & 2047; d = FT + ((size_t)(b * 256)) * 4096 + part * 2048 + tt; cstride = 4096; }
                else { const int rc = r - ML, b = rc >> 8, tt = rc & 255; d = FTC + ((size_t)(b * 256)) * 512 + part * 256 + tt; cstride = 512; }
#pragma unroll
                for (int e = 0; e < 4; ++e) d[(size_t)(ch + e) * cstride] = f2bf(v[e]);
                if (u.pn == 7 && bj == 0 && wc == 0) {
#pragma unroll
                  for (int e = 0; e < 4; ++e) {
                    const int kc = n * 16 + 4 * fq + e;
                    if (kc >= 1 && kc <= 16) d[(size_t)(64 - kc) * cstride] = f2bf(v[e]);
                  }
                }
              }
            }
          }
      }
  }
};
struct EpiRes {
  const float* xin_l; const float* xin_c; float* xout_l; float* xout_c; const float* mod; int gate_off;
  __device__ __forceinline__ void operator()(const f32x4 (&acc)[2][2][4][2], const Unit& u, int wr, int wc, int fr, int fq) const {
    const int mr = (u.pm * 256 < ML) ? ((u.pm * 256) >> 11) : 32;
    const float* gp = mod + (size_t)mr * 6144 + gate_off;
#pragma unroll
    for (int ai = 0; ai < 2; ++ai)
#pragma unroll
      for (int m = 0; m < 4; ++m) {
        const int r = u.pm * 256 + ai * 128 + wr * 64 + m * 16 + fr;
        const float* xi = (r < ML) ? xin_l + (size_t)r * 1024 : xin_c + (size_t)(r - ML) * 1024;
        float* xo = (r < ML) ? xout_l + (size_t)r * 1024 : xout_c + (size_t)(r - ML) * 1024;
#pragma unroll
        for (int bj = 0; bj < 2; ++bj)
#pragma unroll
          for (int n = 0; n < 2; ++n) {
            const int c = u.pn * 256 + bj * 128 + wc * 32 + n * 16 + 4 * fq;
            const float4 g = *reinterpret_cast<const float4*>(gp + c);
            const float4 x = *reinterpret_cast<const float4*>(xi + c);
            const f32x4 v = acc[ai][bj][m][n];
            *reinterpret_cast<float4*>(xo + c) = make_float4(x.x + g.x * v[0], x.y + g.y * v[1], x.z + g.z * v[2], x.w + g.w * v[3]);
          }
      }
  }
};
struct EpiFfn1 {
  u16* HID;
  __device__ __forceinline__ void operator()(const f32x4 (&acc)[2][2][4][2], const Unit& u, int wr, int wc, int fr, int fq) const {
#pragma unroll
    for (int ai = 0; ai < 2; ++ai)
#pragma unroll
      for (int m = 0; m < 4; ++m) {
        const int r = u.pm * 256 + ai * 128 + wr * 64 + m * 16 + fr;
#pragma unroll
        for (int n = 0; n < 2; ++n) {
          const f32x4 g = acc[ai][0][m][n], up = acc[ai][1][m][n];
          const int c = u.pn * 128 + wc * 32 + n * 16 + 4 * fq;
          uint2 w;
          w.x = pack2(silu_f(g[0]) * up[0], silu_f(g[1]) * up[1]);
          w.y = pack2(silu_f(g[2]) * up[2], silu_f(g[3]) * up[3]);
          *reinterpret_cast<uint2*>(HID + (size_t)r * DFF + c) = w;
        }
      }
  }
};
struct EpiFnet {
  u16* Y; int rowbase; int rows_per_b;
  __device__ __forceinline__ void operator()(const f32x4 (&acc)[2][2][4][2], const Unit& u, int wr, int wc, int fr, int fq) const {
#pragma unroll
    for (int ai = 0; ai < 2; ++ai)
#pragma unroll
      for (int m = 0; m < 4; ++m) {
        const size_t r = (size_t)rowbase + (size_t)u.pn * rows_per_b + u.pm * 256 + ai * 128 + wr * 64 + m * 16 + fr;
#pragma unroll
        for (int bj = 0; bj < 2; ++bj)
#pragma unroll
          for (int n = 0; n < 2; ++n) {
            const f32x4 v = acc[ai][bj][m][n];
            const int c = 256 + bj * 128 + wc * 32 + n * 16 + 4 * fq;
            uint2 w; w.x = pack2(v[0], v[1]); w.y = pack2(v[2], v[3]);
            *reinterpret_cast<uint2*>(Y + r * 1024 + c) = w;
          }
      }
  }
};

__device__ __forceinline__ int srccol(int mat, int n) {
  if (mat == 0) {
    if (n < 768) return n;
    if (n < 1024) return 784 + (n - 768);
    if (n < 1280) return 1040 + (n - 1024);
    if (n < 1536) return 1552 + (n - 1280);
    if (n < 1792) return 1808 + (n - 1536);
    return -1;
  }
  if (mat == 1 || mat == 2) {
    const int un = n >> 8, pos = n & 255;
    const int bj = pos >> 7, wc = (pos >> 5) & 3, nn = (pos >> 4) & 1, f = pos & 15;
    if (mat == 1) {
      const int dq = un >> 2, q = un & 3;
      return 2064 + (2 * bj + nn) * 1024 + dq * 256 + 64 * q + 16 * wc + f;
    }
    return un * 256 + 64 * (2 * bj + nn) + 16 * wc + f;
  }
  if (mat == 4) {
    const int pn = n >> 8, bj = (n >> 7) & 1, jj = n & 127;
    return bj * DFF + pn * 128 + jj;
  }
  return n;
}

__device__ __forceinline__ void transpose_tile(const float* __restrict__ src, int ld, int mat, u16* __restrict__ dst, int Kd, int n0, int k0, float* lds) {
  const int tid = tid_l();
  const int nn = tid & 63, kq = tid >> 6;
  const int sc = srccol(mat, n0 + nn);
  float v[32];
#pragma unroll
  for (int i = 0; i < 32; ++i) v[i] = (sc >= 0) ? src[(size_t)(k0 + kq + i * 8) * ld + sc] : 0.f;
#pragma unroll
  for (int i = 0; i < 32; ++i) { const int kk = kq + i * 8; lds[(kk >> 6) * 4160 + (kk & 63) * 65 + nn] = v[i]; }
  __syncthreads();
#pragma unroll
  for (int it = 0; it < 4; ++it) {
    const int e = tid + it * NT, sub = e >> 9, e2 = e & 511, n2 = e2 >> 3, k8 = e2 & 7;
    const float* L = lds + sub * 4160;
    uint4 w;
    w.x = pack2(L[(k8 * 8 + 0) * 65 + n2], L[(k8 * 8 + 1) * 65 + n2]);
    w.y = pack2(L[(k8 * 8 + 2) * 65 + n2], L[(k8 * 8 + 3) * 65 + n2]);
    w.z = pack2(L[(k8 * 8 + 4) * 65 + n2], L[(k8 * 8 + 5) * 65 + n2]);
    w.w = pack2(L[(k8 * 8 + 6) * 65 + n2], L[(k8 * 8 + 7) * 65 + n2]);
    *reinterpret_cast<uint4*>(dst + (size_t)(n0 + n2) * Kd + k0 + sub * 64 + k8 * 8) = w;
  }
  __syncthreads();
}

constexpr int P0_MOD = 192;
constexpr int P0_TPL = 1060;
constexpr int P0_TR = P0_TPL * 4;
constexpr int P0_FF = 256, P0_WF = 256, P0_DFT = 260, P0_SGW = 64;
constexpr int P0_TOTAL = P0_MOD + P0_TR + P0_FF + P0_WF + P0_DFT + P0_SGW;

__device__ __forceinline__ void phase0(const Params& p, char* smem) {
  const int tid = tid_l();
  u16* Wall = reinterpret_cast<u16*>(p.ws + OFF_W);
  float* lds = reinterpret_cast<float*>(smem);
  for (int it = blockIdx.x; it < P0_TOTAL; it += gridDim.x) {
    if (it < P0_MOD) {
      const int kq = it & 3, it4 = it >> 2;
      const int l = it4 / 12, n = (it4 % 12) * 512 + tid;
      const float* aw = p.in[4] + (size_t)l * 1024 * 6144;
      float acc[36];
#pragma unroll
      for (int r = 0; r < 36; ++r) acc[r] = 0.f;
      for (int k0 = kq * 256; k0 < kq * 256 + 256; k0 += 64) {
        __syncthreads();
        for (int e = tid; e < 64 * 36; e += NT) {
          const int kk = e / 36, r = e - kk * 36;
          float v = 0.f;
          if (r < 32) v = silu_f(p.in[1][r * 1024 + k0 + kk]);
          else if (r == 32) v = silu_f(p.in[3][k0 + kk]);
          lds[e] = v;
        }
        __syncthreads();
#pragma unroll 4
        for (int kk = 0; kk < 64; ++kk) {
          const float w = aw[(size_t)(k0 + kk) * 6144 + n];
          const float4* sp = reinterpret_cast<const float4*>(lds + kk * 36);
#pragma unroll
          for (int r4 = 0; r4 < 9; ++r4) {
            const float4 s = sp[r4];
            acc[r4 * 4 + 0] += s.x * w; acc[r4 * 4 + 1] += s.y * w; acc[r4 * 4 + 2] += s.z * w; acc[r4 * 4 + 3] += s.w * w;
          }
        }
      }
      float* modp = reinterpret_cast<float*>(p.ws + OFF_PB) + ((size_t)kq * 4 + l) * 33 * 6144;
#pragma unroll
      for (int r = 0; r < 33; ++r) modp[(size_t)r * 6144 + n] = acc[r];
      __syncthreads();
      continue;
    }
    int q = it - P0_MOD;
    {
      const int NMID = P0_FF + P0_WF + P0_DFT;
      if (q < NMID) q += P0_TR;
      else if (q < NMID + P0_TR) q -= NMID;
    }
    if (q < P0_TR) {
      const int l = q / P0_TPL;
      int r = q - l * P0_TPL;
      u16* Wl = Wall + (size_t)l * LAYER_W;
      if (r < 144) {
        const int ntile = r >> 2, kt = r & 3;
        if (ntile >= 28 && ntile < 36) continue;
        transpose_tile(p.in[8] + (size_t)l * 1024 * DIN, DIN, 0, Wl + WIN_OFF, 1024, ntile * 64, kt * 256, lds);
        continue;
      }
      r -= 144;
      if (r < 256) {
        transpose_tile(p.in[8] + (size_t)l * 1024 * DIN, DIN, 1, Wl + WG_OFF, 1024, (r >> 2) * 64, (r & 3) * 256, lds);
        continue;
      }
      r -= 256;
      if (r < 64) {
        const int kt = r & 3;
        if (kt == 1) continue;
        transpose_tile(p.in[28] + (size_t)l * 1024 * 1024, 1024, 2, Wl + WB_OFF, 1024, (r >> 2) * 64, kt * 256, lds);
        continue;
      }
      r -= 64;
      if (r < 64) {
        transpose_tile(p.in[29] + (size_t)l * 1024 * 1024, 1024, 3, Wl + WO_OFF, 1024, (r >> 2) * 64, (r & 3) * 256, lds);
        continue;
      }
      r -= 64;
      if (r < 352) {
        transpose_tile(p.in[30] + (size_t)l * 1024 * 5632, 5632, 4, Wl + W1_OFF, 1024, (r >> 2) * 64, (r & 3) * 256, lds);
        continue;
      }
      r -= 352;
      if (r < 176) {
        const int ntile = r / 11, kt = r - ntile * 11;
        transpose_tile(p.in[31] + (size_t)l * DFF * 1024, 1024, 5, Wl + W2_OFF, DFF, ntile * 64, kt * 256, lds);
        continue;
      }
      r -= 176;
      {
        transpose_tile(p.in[17] + (size_t)l * 65536, 256, 6, Wl + GLU_OFF, 256, r * 64, 0, lds);
        continue;
      }
    }
    q -= P0_TR;
    if (q < P0_FF) {
      const int l = q >> 6, g = (q >> 4) & 3, kt = q & 15, k0 = kt * 64;
      const float* src = p.in[8] + (size_t)l * 1024 * DIN;
      float* wt = lds;
      float* ct = lds + 64 * 65;
      float* st = ct + 64;
      __syncthreads();
      for (int e = tid; e < 4096; e += NT) {
        const int kk = e >> 6, c = e & 63;
        wt[kk * 65 + c] = src[(size_t)(k0 + kk) * DIN + 1296 + g * 64 + c];
      }
      if (tid < 64) {
        float s, c;
        sincospif((float)tid / 32.f, &s, &c);
        ct[tid] = c; st[tid] = s;
      }
      __syncthreads();
      u16* WinT = Wall + (size_t)l * LAYER_W + WIN_OFF;
      for (int e = tid; e < 4096; e += NT) {
        const int j = e >> 6, kk = e & 63;
        float sc = 0.f, ss = 0.f;
        for (int c = 0; c < 64; ++c) {
          const float w = wt[kk * 65 + c];
          const int m = (c * j) & 63;
          sc += w * ct[m];
          ss += w * st[m];
        }
        if (g == 0 && j >= 48) sc = src[(size_t)(k0 + kk) * DIN + 768 + (j - 48)];
        WinT[(size_t)(1792 + g * 64 + j) * 1024 + k0 + kk] = f2bf(sc);
        WinT[(size_t)(2048 + g * 64 + j) * 1024 + k0 + kk] = f2bf(ss);
      }
      __syncthreads();
      continue;
    }
    q -= P0_FF;
    if (q < P0_WF) {
      const int l = q >> 6, g = (q >> 4) & 3, dt = q & 15, d0 = dt * 64;
      float* wb = lds;
      float* fw = lds + 64 * 65;
      __syncthreads();
      for (int e2 = tid; e2 < 4096; e2 += NT) {
        const int e = e2 >> 6, dd = e2 & 63;
        wb[e * 65 + dd] = p.in[28][((size_t)(l * 4 + 1) * 256 + g * 64 + e) * 1024 + d0 + dd];
        fw[e * 65 + dd] = p.in[19][((size_t)(l * 4 + g) * 64 + e) * 64 + dd];
      }
      __syncthreads();
      u16* WbT = Wall + (size_t)l * LAYER_W + WB_OFF;
      for (int e2 = tid; e2 < 4096; e2 += NT) {
        const int c = e2 & 63, dd = e2 >> 6;
        float v = 0.f;
        for (int e = 0; e < 64; ++e) v += fw[c * 65 + e] * wb[e * 65 + dd];
        const int dfull = d0 + dd, dl = dfull & 255, qq = dl >> 6, xx = dl & 63;
        const int prow = (dfull & ~255) + 128 * (qq >> 1) + 32 * (xx >> 4) + 16 * (qq & 1) + (xx & 15);
        WbT[(size_t)prow * 1024 + 256 + g * 64 + c] = f2bf(v);
      }
      __syncthreads();
      continue;
    }
    q -= P0_WF;
    if (q < P0_DFT) {
      if (q < 256) {
        u16* DL = reinterpret_cast<u16*>(p.ws + OFF_DL);
        const float scale = 0.0027621358640099515f;
        for (int e = tid; e < 4096; e += NT) {
          const int k = q * 8 + (e >> 9), c8 = e & 511, col0 = c8 * 8;
          const int part = col0 >= 2048, l0 = col0 & 2047;
          unsigned w[4];
#pragma unroll
          for (int jj = 0; jj < 8; jj += 2) {
            float s0, c0, s1, c1;
            sincospif((float)((k * (l0 + jj)) & 2047) / 1024.f, &s0, &c0);
            sincospif((float)((k * (l0 + jj + 1)) & 2047) / 1024.f, &s1, &c1);
            const float v0 = (part ? -s0 : c0) * scale, v1 = (part ? -s1 : c1) * scale;
            w[jj >> 1] = pack2(v0, v1);
          }
          *reinterpret_cast<uint4*>(DL + (size_t)k * 4096 + col0) = make_uint4(w[0], w[1], w[2], w[3]);
        }
      } else {
        u16* DC = reinterpret_cast<u16*>(p.ws + OFF_DC);
        const float scale = 1.f / 128.f;
        const int qq = q - 256;
        for (int e = tid; e < 4096; e += NT) {
          const int k = qq * 64 + (e >> 6), c8 = e & 63, col0 = c8 * 8;
          const int part = col0 >= 256, l0 = col0 & 255;
          unsigned w[4];
#pragma unroll
          for (int jj = 0; jj < 8; jj += 2) {
            float s0, c0, s1, c1;
            sincospif((float)((k * (l0 + jj)) & 255) / 128.f, &s0, &c0);
            sincospif((float)((k * (l0 + jj + 1)) & 255) / 128.f, &s1, &c1);
            const float v0 = (part ? -s0 : c0) * scale, v1 = (part ? -s1 : c1) * scale;
            w[jj >> 1] = pack2(v0, v1);
          }
          *reinterpret_cast<uint4*>(DC + (size_t)k * 512 + col0) = make_uint4(w[0], w[1], w[2], w[3]);
        }
      }
      continue;
    }
    q -= P0_DFT;
    {
      u16* SGW = reinterpret_cast<u16*>(p.ws + OFF_SGW);
      for (int e = tid; e < 4096; e += NT) {
        const int idx = q * 4096 + e;
        SGW[idx] = f2bf(p.in[26][idx]);
      }
    }
  }
}

__device__ __forceinline__ void mod_combine(const Params& p) {
  const float* modp = reinterpret_cast<const float*>(p.ws + OFF_PB);
  float* mod = reinterpret_cast<float*>(p.ws + OFF_MOD);
  const int total = 4 * 33 * 6144, Q = 4 * 33 * 6144;
  for (int i = blockIdx.x * NT + tid_l(); i < total; i += gridDim.x * NT) {
    const int l = i / (33 * 6144), n = i % 6144;
    mod[i] = ((modp[i] + modp[Q + i]) + (modp[2 * Q + i] + modp[3 * Q + i])) + p.in[5][l * 6144 + n];
  }
}

__device__ __forceinline__ int mod_row(int r) { return r < ML ? (r >> 11) : 32; }

__device__ __forceinline__ void phase_norm(const Params& p, int l, int which, int Mrows) {
  const int tid = tid_l();
  const int lane = tid & 63;
  const int gw = blockIdx.x * NW + (tid >> 6), tw = gridDim.x * NW;
  const float* nw = p.in[which ? 7 : 6] + l * 1024;
  const float* mod = reinterpret_cast<const float*>(p.ws + OFF_MOD) + (size_t)l * 33 * 6144;
  const int sh_off = which ? 3072 : 0, sc_off = which ? 4096 : 1024;
  u16* H = reinterpret_cast<u16*>(p.ws + OFF_H);
  const bool first = (l == 0 && which == 0);
  for (int r0 = gw * 4; r0 < Mrows; r0 += tw * 4) {
    const float* xr;
    if (r0 < ML) xr = (first ? p.in[0] : p.out) + (size_t)r0 * 1024;
    else xr = (first ? p.in[2] : reinterpret_cast<const float*>(p.ws + OFF_XC)) + (size_t)(r0 - ML) * 1024;
    float4 v[4][4];
#pragma unroll
    for (int j = 0; j < 4; ++j)
#pragma unroll
      for (int i = 0; i < 4; ++i) v[j][i] = *reinterpret_cast<const float4*>(xr + j * 1024 + i * 256 + lane * 4);
    float rs[4];
#pragma unroll
    for (int j = 0; j < 4; ++j) {
      float ss = 0.f;
#pragma unroll
      for (int i = 0; i < 4; ++i) ss += v[j][i].x * v[j][i].x + v[j][i].y * v[j][i].y + v[j][i].z * v[j][i].z + v[j][i].w * v[j][i].w;
      ss = reduce8(ss);
      ss += dpp_f<0x140>(ss);
      ss += __shfl_xor(ss, 16);
      ss += __shfl_xor(ss, 32);
      rs[j] = rsqrtf(ss * (1.f / 1024.f) + EPS);
    }
    const float* mr = mod + (size_t)mod_row(r0) * 6144;
#pragma unroll
    for (int i = 0; i < 4; ++i) {
      const int c = i * 256 + lane * 4;
      const float4 g = *reinterpret_cast<const float4*>(nw + c);
      const float4 sc = *reinterpret_cast<const float4*>(mr + sc_off + c);
      const float4 sh = *reinterpret_cast<const float4*>(mr + sh_off + c);
      const float m0 = g.x * (1.f + sc.x), m1 = g.y * (1.f + sc.y), m2 = g.z * (1.f + sc.z), m3 = g.w * (1.f + sc.w);
#pragma unroll
      for (int j = 0; j < 4; ++j) {
        uint2 w;
        w.x = pack2(v[j][i].x * rs[j] * m0 + sh.x, v[j][i].y * rs[j] * m1 + sh.y);
        w.y = pack2(v[j][i].z * rs[j] * m2 + sh.z, v[j][i].w * rs[j] * m3 + sh.w);
        *reinterpret_cast<uint2*>(H + (size_t)(r0 + j) * 1024 + c) = w;
      }
    }
  }
}

__device__ __forceinline__ void phase_proj(const Params& p, int l, char* smem) {
  const u16* H = reinterpret_cast<const u16*>(p.ws + OFF_H);
  const u16* WinT = reinterpret_cast<const u16*>(p.ws + OFF_W) + (size_t)l * LAYER_W + WIN_OFF;
  EpiProj E;
  E.PB = reinterpret_cast<u16*>(p.ws + OFF_PB);
  E.FT = reinterpret_cast<u16*>(p.ws + OFF_FT);
  E.FTC = reinterpret_cast<u16*>(p.ws + OFF_FTC);
  E.AB = reinterpret_cast<float*>(p.ws + OFF_AB);
  if (l < DEPTH - 1) {
    SchedStd S;
    S.init(MT / 256, NPROJ / 256, 1024, H, (size_t)256 * 1024 * 2, WinT, (size_t)256 * 1024 * 2);
    gemm_phase((PG8_LAS unsigned char*)(smem), 1024, 1024, S, E);
  } else {
    SchedProjLast S;
    S.s.init(ML / 256, NPROJ / 256, 1024, H, (size_t)256 * 1024 * 2, WinT, (size_t)256 * 1024 * 2);
    gemm_phase((PG8_LAS unsigned char*)(smem), 1024, 1024, S, E);
  }
}

typedef float f32x2 __attribute__((ext_vector_type(2)));
__device__ __forceinline__ void gdn_block(const Params& p, int l, int b, int h, int dir, char* smem, bool ctx_out) {
  const int tid = tid_l(), lane = tid & 63, wid = tid >> 6;
  float* Lbase = reinterpret_cast<float*>(smem);
  constexpr int BUFSZ = 3 * 32 * 68 + 128 + 32 + 64 * 36;
  float* Lo_base = Lbase + 2 * BUFSZ;
  const u16* PB = reinterpret_cast<const u16*>(p.ws + OFF_PB);
  const float* AB = reinterpret_cast<const float*>(p.ws + OFF_AB);
  u16* O = reinterpret_cast<u16*>(p.ws + (dir ? OFF_OGB : OFF_OGF));
  const float Acoef = -__expf(p.in[21][l * 8 + dir * 4 + h]);
  const float dtb = p.in[22][l * 8 + dir * 4 + h];
  const int pj = tid >> 4, oc = tid & 15;
  float wreg[3][12];
  {
    const float* cw = p.in[20] + (size_t)l * 3 * 256 * 3;
#pragma unroll
    for (int x = 0; x < 3; ++x) {
      const float4* wp = reinterpret_cast<const float4*>(cw + (size_t)(x * 256 + h * 64 + oc * 4) * 3);
#pragma unroll
      for (int i = 0; i < 3; ++i) { const float4 t = wp[i]; wreg[x][i * 4] = t.x; wreg[x][i * 4 + 1] = t.y; wreg[x][i * 4 + 2] = t.z; wreg[x][i * 4 + 3] = t.w; }
    }
  }
  f32x4 Sacc[4];
#pragma unroll
  for (int i = 0; i < 4; ++i) Sacc[i] = f32x4{0.f, 0.f, 0.f, 0.f};
  uint2 rg[3][3];
  float ral = 0.f, rbl = 0.f;
  constexpr int NCH = (CTXL + SEQ) / 32;
  auto issue_loads = [&](int cc) {
    const int seg = cc >= CTXL / 32, c0 = seg ? cc - CTXL / 32 : cc;
    const int Ls = seg ? SEQ : CTXL, rowbase = seg ? b * SEQ : ML + b * CTXL;
    const int tpos = dir ? (Ls - 1 - (c0 * 32 + pj)) : (c0 * 32 + pj);
    const size_t row = (size_t)(rowbase + tpos);
    const bool vm = tpos > 0, vp = tpos < Ls - 1;
#pragma unroll
    for (int x = 0; x < 3; ++x) {
      const u16* s0 = PB + row * PBW + (x == 0 ? PB_K : (x == 1 ? PB_V : PB_Q)) + h * 64 + oc * 4;
      rg[x][1] = *reinterpret_cast<const uint2*>(s0);
      rg[x][0] = make_uint2(0, 0); rg[x][2] = make_uint2(0, 0);
      if (vm) rg[x][0] = *reinterpret_cast<const uint2*>(s0 - PBW);
      if (vp) rg[x][2] = *reinterpret_cast<const uint2*>(s0 + PBW);
    }
    if (oc == 0) { ral = AB[row * 16 + dir * 4 + h]; rbl = AB[row * 16 + 8 + dir * 4 + h]; }
  };
  auto write_out = [&](int cc) {
    const int seg = cc >= CTXL / 32, c0 = seg ? cc - CTXL / 32 : cc;
    if (!(seg || ctx_out)) return;
    const int Ls = seg ? SEQ : CTXL, rowbase = seg ? b * SEQ : ML + b * CTXL;
    const int tpos = dir ? (Ls - 1 - (c0 * 32 + pj)) : (c0 * 32 + pj);
    const float4 o4 = *reinterpret_cast<const float4*>(Lo_base + (cc & 1) * 2048 + pj * 64 + oc * 4);
    uint2 w; w.x = pack2(o4.x, o4.y); w.y = pack2(o4.z, o4.w);
    *reinterpret_cast<uint2*>(O + (size_t)(rowbase + tpos) * 256 + h * 64 + oc * 4) = w;
  };
  __syncthreads();
  issue_loads(0);
#pragma unroll 1
  for (int cc = 0; cc < NCH; ++cc) {
    float* Lk = Lbase + (cc & 1) * BUFSZ;
    float* Lq = Lk + 32 * 68;
    float* Lv = Lq + 32 * 68;
    float4* Lc = reinterpret_cast<float4*>(Lv + 32 * 68);
    float yk[4] = {0.f, 0.f, 0.f, 0.f};
    float qkd = 0.f;
#pragma unroll
    for (int x = 0; x < 3; ++x) {
      float y[4];
      float ss = 0.f;
#pragma unroll
      for (int e = 0; e < 4; ++e) {
        const unsigned wm = (e < 2) ? rg[x][0].x : rg[x][0].y, w0 = (e < 2) ? rg[x][1].x : rg[x][1].y, wpp = (e < 2) ? rg[x][2].x : rg[x][2].y;
        const float xm = (e & 1) ? hi2f(wm) : lo2f(wm), x0 = (e & 1) ? hi2f(w0) : lo2f(w0), xp = (e & 1) ? hi2f(wpp) : lo2f(wpp);
        float v = wreg[x][e * 3 + 0] * xm + wreg[x][e * 3 + 1] * x0 + wreg[x][e * 3 + 2] * xp;
        v = silu_f(v);
        y[e] = v;
        ss += v * v;
      }
      if (x != 1) {
        ss = reduce16(ss);
        float sc = rsqrtf(ss + EPS);
        if (x == 2) sc *= 0.125f;
#pragma unroll
        for (int e = 0; e < 4; ++e) y[e] *= sc;
      }
      if (x == 0) {
        float* LkT = Lk + 3 * 32 * 68 + 160;
#pragma unroll
        for (int e = 0; e < 4; ++e) { yk[e] = y[e]; LkT[(oc * 4 + e) * 36 + pj] = y[e]; }
      }
      if (x == 2) {
        float d = y[0] * yk[0] + y[1] * yk[1] + y[2] * yk[2] + y[3] * yk[3];
        d = reduce16(d);
        qkd = d;
      }
      float* dst = (x == 0 ? Lk : (x == 1 ? Lv : Lq)) + pj * 68 + oc * 4;
      *reinterpret_cast<float4*>(dst) = make_float4(y[0], y[1], y[2], y[3]);
    }
    if (oc == 0) { const float gl = Acoef * softplus_f(ral + dtb); Lc[pj] = make_float4(__expf(gl), sigm(rbl), qkd, gl); }
    __syncthreads();
    if (cc > 0) write_out(cc - 1);
    if (cc + 1 < NCH) issue_loads(cc + 1);
    if (wid < 4) {
      float* Lo = Lo_base + (cc & 1) * 2048;
      float* W = Lo_base + 4096 + wid * 1408;
      float* A1 = W; float* A2 = W + 256; float* KSs = W + 512; float* QSs = W + 768; float* DlT = W + 1024;
      float* Cs = W + 1280; float* Ecs = W + 1296; float* E15 = W + 1312; float* Bts = W + 1328;
      const float* LkT = Lk + 3 * 32 * 68 + 160;
      const int fr = lane & 15, fq = lane >> 4, vq = lane >> 2, sq = lane & 3;
      const float4* Lc4 = reinterpret_cast<const float4*>(Lv + 32 * 68);
#pragma unroll 1
      for (int mc = 0; mc < 2; ++mc) {
        const int tb = mc * 16;
        {
          float ct = 0.f, c15 = 0.f;
#pragma unroll
          for (int j = 0; j < 16; ++j) { const float gj = Lc4[tb + j].w; c15 += gj; ct += (j <= fr) ? gj : 0.f; }
          if (lane < 16) { Cs[lane] = ct; Ecs[lane] = __expf(ct); E15[lane] = __expf(c15 - ct); Bts[lane] = Lc4[tb + lane].y; }
        }
        bf16x8 kf[2], qf[2], kp[2], qp[2];
#pragma unroll
        for (int ks = 0; ks < 2; ++ks) {
          const float* kr = Lk + (tb + fr) * 68;
          const float* qr = Lq + (tb + fr) * 68;
          const float4 a0 = *reinterpret_cast<const float4*>(kr + ks * 32 + fq * 8), a1 = *reinterpret_cast<const float4*>(kr + ks * 32 + fq * 8 + 4);
          const float4 b0 = *reinterpret_cast<const float4*>(qr + ks * 32 + fq * 8), b1 = *reinterpret_cast<const float4*>(qr + ks * 32 + fq * 8 + 4);
          const float4 c0 = *reinterpret_cast<const float4*>(kr + (2 * ks) * 16 + fq * 4), c1 = *reinterpret_cast<const float4*>(kr + (2 * ks + 1) * 16 + fq * 4);
          const float4 d0 = *reinterpret_cast<const float4*>(qr + (2 * ks) * 16 + fq * 4), d1 = *reinterpret_cast<const float4*>(qr + (2 * ks + 1) * 16 + fq * 4);
          const uint4 ua = make_uint4(pack2(a0.x, a0.y), pack2(a0.z, a0.w), pack2(a1.x, a1.y), pack2(a1.z, a1.w));
          const uint4 ub = make_uint4(pack2(b0.x, b0.y), pack2(b0.z, b0.w), pack2(b1.x, b1.y), pack2(b1.z, b1.w));
          const uint4 uc = make_uint4(pack2(c0.x, c0.y), pack2(c0.z, c0.w), pack2(c1.x, c1.y), pack2(c1.z, c1.w));
          const uint4 ud = make_uint4(pack2(d0.x, d0.y), pack2(d0.z, d0.w), pack2(d1.x, d1.y), pack2(d1.z, d1.w));
          kf[ks] = __builtin_bit_cast(bf16x8, ua); qf[ks] = __builtin_bit_cast(bf16x8, ub);
          kp[ks] = __builtin_bit_cast(bf16x8, uc); qp[ks] = __builtin_bit_cast(bf16x8, ud);
        }
        f32x4 g1 = f32x4{0.f, 0.f, 0.f, 0.f}, g2 = f32x4{0.f, 0.f, 0.f, 0.f}, ks0 = f32x4{0.f, 0.f, 0.f, 0.f}, qs0 = f32x4{0.f, 0.f, 0.f, 0.f};
#pragma unroll
        for (int ks = 0; ks < 2; ++ks) {
          const uint4 us = make_uint4(pack2(Sacc[2 * ks][0], Sacc[2 * ks][1]), pack2(Sacc[2 * ks][2], Sacc[2 * ks][3]),
                                      pack2(Sacc[2 * ks + 1][0], Sacc[2 * ks + 1][1]), pack2(Sacc[2 * ks + 1][2], Sacc[2 * ks + 1][3]));
          const bf16x8 sf = __builtin_bit_cast(bf16x8, us);
          g1 = __builtin_amdgcn_mfma_f32_16x16x32_bf16(kf[ks], kf[ks], g1, 0, 0, 0);
          g2 = __builtin_amdgcn_mfma_f32_16x16x32_bf16(qf[ks], kf[ks], g2, 0, 0, 0);
          ks0 = __builtin_amdgcn_mfma_f32_16x16x32_bf16(kp[ks], sf, ks0, 0, 0, 0);
          qs0 = __builtin_amdgcn_mfma_f32_16x16x32_bf16(qp[ks], sf, qs0, 0, 0, 0);
        }
        WAVE_SYNC();
        {
          const float cs = Cs[fr];
          const float4 ct4 = *reinterpret_cast<const float4*>(Cs + fq * 4);
          const float4 bt4 = *reinterpret_cast<const float4*>(Bts + fq * 4);
          const float ctv[4] = {ct4.x, ct4.y, ct4.z, ct4.w}, btv[4] = {bt4.x, bt4.y, bt4.z, bt4.w};
#pragma unroll
          for (int i = 0; i < 4; ++i) {
            const int t = fq * 4 + i;
            const float e = __expf(fminf(ctv[i] - cs, 0.f));
            A1[t * 16 + fr] = (fr < t) ? btv[i] * g1[i] * e : 0.f;
            A2[t * 16 + fr] = (fr <= t) ? g2[i] * e : 0.f;
            KSs[t * 16 + fr] = ks0[i];
            QSs[t * 16 + fr] = qs0[i];
          }
        }
        WAVE_SYNC();
        float dreg[4] = {0.f, 0.f, 0.f, 0.f};
        float na1[4], na2[4], nbt, nec, nv, nks, nqs;
#pragma unroll
        for (int j = 0; j < 4; ++j) { na1[j] = A1[sq + 4 * j]; na2[j] = A2[sq + 4 * j]; }
        nbt = Bts[0]; nec = Ecs[0]; nv = Lv[tb * 68 + wid * 16 + vq]; nks = KSs[vq]; nqs = QSs[vq];
#pragma unroll
        for (int t = 0; t < 16; ++t) {
          float a1[4], a2[4];
#pragma unroll
          for (int j = 0; j < 4; ++j) { a1[j] = na1[j]; a2[j] = na2[j]; }
          const float bt = nbt, ec = nec, vv = nv, ksv = nks, qsv = nqs;
          if (t < 15) {
#pragma unroll
            for (int j = 0; j < (t + 4) / 4; ++j) na1[j] = A1[(t + 1) * 16 + sq + 4 * j];
#pragma unroll
            for (int j = 0; j <= ((t + 1) >> 2); ++j) na2[j] = A2[(t + 1) * 16 + sq + 4 * j];
            nbt = Bts[t + 1]; nec = Ecs[t + 1]; nv = Lv[(tb + t + 1) * 68 + wid * 16 + vq]; nks = KSs[(t + 1) * 16 + vq]; nqs = QSs[(t + 1) * 16 + vq];
          }
          float part = 0.f;
#pragma unroll
          for (int j = 0; j < (t + 3) / 4; ++j) part += a1[j] * dreg[j];
          part = reduce4(part);
          const float dt = bt * vv - bt * ec * ksv - part;
          dreg[t >> 2] = (sq == (t & 3)) ? dt : dreg[t >> 2];
          float po = 0.f;
#pragma unroll
          for (int j = 0; j <= (t >> 2); ++j) po += a2[j] * dreg[j];
          po = reduce4(po);
          Lo[(tb + t) * 64 + wid * 16 + vq] = ec * qsv + po;
          DlT[vq * 16 + t] = dt;
        }
        WAVE_SYNC();
        {
          const float Dd = Ecs[15];
          bf16x8 df = {0, 0, 0, 0, 0, 0, 0, 0};
          float4 e0 = make_float4(0.f, 0.f, 0.f, 0.f), e1 = e0;
          if (fq < 2) {
            const float4 x0 = *reinterpret_cast<const float4*>(DlT + fr * 16 + fq * 8), x1 = *reinterpret_cast<const float4*>(DlT + fr * 16 + fq * 8 + 4);
            const uint4 ux = make_uint4(pack2(x0.x, x0.y), pack2(x0.z, x0.w), pack2(x1.x, x1.y), pack2(x1.z, x1.w));
            df = __builtin_bit_cast(bf16x8, ux);
            e0 = *reinterpret_cast<const float4*>(E15 + fq * 8); e1 = *reinterpret_cast<const float4*>(E15 + fq * 8 + 4);
          }
#pragma unroll
          for (int mt = 0; mt < 4; ++mt) {
            bf16x8 kt = {0, 0, 0, 0, 0, 0, 0, 0};
            if (fq < 2) {
              const float4 x0 = *reinterpret_cast<const float4*>(LkT + (mt * 16 + fr) * 36 + tb + fq * 8), x1 = *reinterpret_cast<const float4*>(LkT + (mt * 16 + fr) * 36 + tb + fq * 8 + 4);
              const uint4 ux = make_uint4(pack2(x0.x * e0.x, x0.y * e0.y), pack2(x0.z * e0.z, x0.w * e0.w), pack2(x1.x * e1.x, x1.y * e1.y), pack2(x1.z * e1.z, x1.w * e1.w));
              kt = __builtin_bit_cast(bf16x8, ux);
            }
            f32x4 sc = Sacc[mt];
            sc[0] *= Dd; sc[1] *= Dd; sc[2] *= Dd; sc[3] *= Dd;
            Sacc[mt] = __builtin_amdgcn_mfma_f32_16x16x32_bf16(kt, df, sc, 0, 0, 0);
          }
        }
        WAVE_SYNC();
      }
    }
  }
  __syncthreads();
  write_out(NCH - 1);
}

__device__ __forceinline__ void gdn_block3(const Params& p, int l, int b, int h, int dir, char* smem, bool ctx_out) {
  const int tid = tid_l(), lane = tid & 63, wid = tid >> 6;
  float* Lbase = reinterpret_cast<float*>(smem);
  constexpr int BUFSZ = 3 * 32 * 68 + 128 + 32 + 64 * 36;
  float* Lo_base = Lbase + 2 * BUFSZ;
  float* Lw = Lo_base + 4096 + 4 * 1408;
  const u16* PB = reinterpret_cast<const u16*>(p.ws + OFF_PB);
  const float* AB = reinterpret_cast<const float*>(p.ws + OFF_AB);
  u16* O = reinterpret_cast<u16*>(p.ws + (dir ? OFF_OGB : OFF_OGF));
  const float Acoef = -__expf(p.in[21][l * 8 + dir * 4 + h]);
  const float dtb = p.in[22][l * 8 + dir * 4 + h];
  const int t2 = tid & 255, pj = t2 >> 3, oc = t2 & 7;
  __syncthreads();
  {
    const float* cw = p.in[20] + (size_t)l * 3 * 256 * 3;
    for (int e = tid; e < 576; e += NT) { const int x = e / 192, r = e - x * 192; Lw[e] = cw[(size_t)(x * 256 + h * 64) * 3 + r]; }
  }
  __syncthreads();
  f32x4 Sacc[4];
#pragma unroll
  for (int i = 0; i < 4; ++i) Sacc[i] = f32x4{0.f, 0.f, 0.f, 0.f};
  constexpr int NCH = (CTXL + SEQ) / 32;
  auto prep_chunk = [&](int cc) {
    const int seg = cc >= CTXL / 32, c0 = seg ? cc - CTXL / 32 : cc;
    const int Ls = seg ? SEQ : CTXL, rowbase = seg ? b * SEQ : ML + b * CTXL;
    const int tpos = dir ? (Ls - 1 - (c0 * 32 + pj)) : (c0 * 32 + pj);
    const size_t row = (size_t)(rowbase + tpos);
    const bool vm = tpos > 0, vp = tpos < Ls - 1;
    uint4 rg[3][3];
#pragma unroll
    for (int x = 0; x < 3; ++x) {
      const u16* s0 = PB + row * PBW + (x == 0 ? PB_K : (x == 1 ? PB_V : PB_Q)) + h * 64 + oc * 8;
      rg[x][1] = *reinterpret_cast<const uint4*>(s0);
      rg[x][0] = make_uint4(0, 0, 0, 0); rg[x][2] = make_uint4(0, 0, 0, 0);
      if (vm) rg[x][0] = *reinterpret_cast<const uint4*>(s0 - PBW);
      if (vp) rg[x][2] = *reinterpret_cast<const uint4*>(s0 + PBW);
    }
    float ral = 0.f, rbl = 0.f;
    if (oc == 0) { ral = AB[row * 16 + dir * 4 + h]; rbl = AB[row * 16 + 8 + dir * 4 + h]; }
    float* Lk = Lbase + (cc & 1) * BUFSZ;
    float* Lq = Lk + 32 * 68;
    float* Lv = Lq + 32 * 68;
    float4* Lc = reinterpret_cast<float4*>(Lv + 32 * 68);
    float* LkT = Lk + 3 * 32 * 68 + 160;
#pragma unroll
    for (int x = 0; x < 3; ++x) {
      float y[8];
      float ss = 0.f;
      const unsigned am[4] = {rg[x][0].x, rg[x][0].y, rg[x][0].z, rg[x][0].w};
      const unsigned a0[4] = {rg[x][1].x, rg[x][1].y, rg[x][1].z, rg[x][1].w};
      const unsigned ap[4] = {rg[x][2].x, rg[x][2].y, rg[x][2].z, rg[x][2].w};
      const float4* wq = reinterpret_cast<const float4*>(Lw + x * 192 + oc * 24);
      float wv[24];
#pragma unroll
      for (int i = 0; i < 6; ++i) { const float4 t4 = wq[i]; wv[i * 4] = t4.x; wv[i * 4 + 1] = t4.y; wv[i * 4 + 2] = t4.z; wv[i * 4 + 3] = t4.w; }
#pragma unroll
      for (int e = 0; e < 8; ++e) {
        const float xm = (e & 1) ? hi2f(am[e >> 1]) : lo2f(am[e >> 1]);
        const float x0 = (e & 1) ? hi2f(a0[e >> 1]) : lo2f(a0[e >> 1]);
        const float xp = (e & 1) ? hi2f(ap[e >> 1]) : lo2f(ap[e >> 1]);
        float v = wv[e * 3 + 0] * xm + wv[e * 3 + 1] * x0 + wv[e * 3 + 2] * xp;
        v = silu_f(v);
        y[e] = v;
        ss += v * v;
      }
      if (x != 1) {
        ss = reduce8(ss);
        float sc = rsqrtf(ss + EPS);
        if (x == 2) sc *= 0.125f;
#pragma unroll
        for (int e = 0; e < 8; ++e) y[e] *= sc;
      }
      if (x == 0) {
#pragma unroll
        for (int e = 0; e < 8; ++e) LkT[(oc * 8 + e) * 36 + pj] = y[e];
      }
      float* dst = (x == 0 ? Lk : (x == 1 ? Lv : Lq)) + pj * 68 + oc * 8;
      *reinterpret_cast<float4*>(dst) = make_float4(y[0], y[1], y[2], y[3]);
      *reinterpret_cast<float4*>(dst + 4) = make_float4(y[4], y[5], y[6], y[7]);
    }
    if (oc == 0) { const float gl = Acoef * softplus_f(ral + dtb); Lc[pj] = make_float4(__expf(gl), sigm(rbl), 0.f, gl); }
  };
  auto write_out = [&](int cc) {
    const int seg = cc >= CTXL / 32, c0 = seg ? cc - CTXL / 32 : cc;
    if (!(seg || ctx_out)) return;
    const int Ls = seg ? SEQ : CTXL, rowbase = seg ? b * SEQ : ML + b * CTXL;
    const int tpos = dir ? (Ls - 1 - (c0 * 32 + pj)) : (c0 * 32 + pj);
    const float4 oa = *reinterpret_cast<const float4*>(Lo_base + (cc & 1) * 2048 + pj * 64 + oc * 8);
    const float4 ob = *reinterpret_cast<const float4*>(Lo_base + (cc & 1) * 2048 + pj * 64 + oc * 8 + 4);
    uint4 w; w.x = pack2(oa.x, oa.y); w.y = pack2(oa.z, oa.w); w.z = pack2(ob.x, ob.y); w.w = pack2(ob.z, ob.w);
    *reinterpret_cast<uint4*>(O + (size_t)(rowbase + tpos) * 256 + h * 64 + oc * 8) = w;
  };
  if (wid >= 4) prep_chunk(0);
  __syncthreads();
#pragma unroll 1
  for (int cc = 0; cc < NCH; ++cc) {
    if (wid >= 4) {
      if (cc > 0) write_out(cc - 1);
      if (cc + 1 < NCH) prep_chunk(cc + 1);
    } else {
      float* Lk = Lbase + (cc & 1) * BUFSZ;
      float* Lq = Lk + 32 * 68;
      float* Lv = Lq + 32 * 68;
    {
      float* Lo = Lo_base + (cc & 1) * 2048;
      float* W = Lo_base + 4096 + wid * 1408;
      float* A1 = W; float* A2 = W + 256; float* KSs = W + 512; float* QSs = W + 768; float* DlT = W + 1024;
      float* Cs = W + 1280; float* Ecs = W + 1296; float* E15 = W + 1312; float* Bts = W + 1328;
      const float* LkT = Lk + 3 * 32 * 68 + 160;
      const int fr = lane & 15, fq = lane >> 4, vq = lane >> 2, sq = lane & 3;
      const float4* Lc4 = reinterpret_cast<const float4*>(Lv + 32 * 68);
#pragma unroll 1
      for (int mc = 0; mc < 2; ++mc) {
        const int tb = mc * 16;
        {
          float ct = 0.f, c15 = 0.f;
#pragma unroll
          for (int j = 0; j < 16; ++j) { const float gj = Lc4[tb + j].w; c15 += gj; ct += (j <= fr) ? gj : 0.f; }
          if (lane < 16) { Cs[lane] = ct; Ecs[lane] = __expf(ct); E15[lane] = __expf(c15 - ct); Bts[lane] = Lc4[tb + lane].y; }
        }
        bf16x8 kf[2], qf[2], kp[2], qp[2];
#pragma unroll
        for (int ks = 0; ks < 2; ++ks) {
          const float* kr = Lk + (tb + fr) * 68;
          const float* qr = Lq + (tb + fr) * 68;
          const float4 a0 = *reinterpret_cast<const float4*>(kr + ks * 32 + fq * 8), a1 = *reinterpret_cast<const float4*>(kr + ks * 32 + fq * 8 + 4);
          const float4 b0 = *reinterpret_cast<const float4*>(qr + ks * 32 + fq * 8), b1 = *reinterpret_cast<const float4*>(qr + ks * 32 + fq * 8 + 4);
          const float4 c0 = *reinterpret_cast<const float4*>(kr + (2 * ks) * 16 + fq * 4), c1 = *reinterpret_cast<const float4*>(kr + (2 * ks + 1) * 16 + fq * 4);
          const float4 d0 = *reinterpret_cast<const float4*>(qr + (2 * ks) * 16 + fq * 4), d1 = *reinterpret_cast<const float4*>(qr + (2 * ks + 1) * 16 + fq * 4);
          const uint4 ua = make_uint4(pack2(a0.x, a0.y), pack2(a0.z, a0.w), pack2(a1.x, a1.y), pack2(a1.z, a1.w));
          const uint4 ub = make_uint4(pack2(b0.x, b0.y), pack2(b0.z, b0.w), pack2(b1.x, b1.y), pack2(b1.z, b1.w));
          const uint4 uc = make_uint4(pack2(c0.x, c0.y), pack2(c0.z, c0.w), pack2(c1.x, c1.y), pack2(c1.z, c1.w));
          const uint4 ud = make_uint4(pack2(d0.x, d0.y), pack2(d0.z, d0.w), pack2(d1.x, d1.y), pack2(d1.z, d1.w));
          kf[ks] = __builtin_bit_cast(bf16x8, ua); qf[ks] = __builtin_bit_cast(bf16x8, ub);
          kp[ks] = __builtin_bit_cast(bf16x8, uc); qp[ks] = __builtin_bit_cast(bf16x8, ud);
        }
        f32x4 g1 = f32x4{0.f, 0.f, 0.f, 0.f}, g2 = f32x4{0.f, 0.f, 0.f, 0.f}, ks0 = f32x4{0.f, 0.f, 0.f, 0.f}, qs0 = f32x4{0.f, 0.f, 0.f, 0.f};
#pragma unroll
        for (int ks = 0; ks < 2; ++ks) {
          const uint4 us = make_uint4(pack2(Sacc[2 * ks][0], Sacc[2 * ks][1]), pack2(Sacc[2 * ks][2], Sacc[2 * ks][3]),
                                      pack2(Sacc[2 * ks + 1][0], Sacc[2 * ks + 1][1]), pack2(Sacc[2 * ks + 1][2], Sacc[2 * ks + 1][3]));
          const bf16x8 sf = __builtin_bit_cast(bf16x8, us);
          g1 = __builtin_amdgcn_mfma_f32_16x16x32_bf16(kf[ks], kf[ks], g1, 0, 0, 0);
          g2 = __builtin_amdgcn_mfma_f32_16x16x32_bf16(qf[ks], kf[ks], g2, 0, 0, 0);
          ks0 = __builtin_amdgcn_mfma_f32_16x16x32_bf16(kp[ks], sf, ks0, 0, 0, 0);
          qs0 = __builtin_amdgcn_mfma_f32_16x16x32_bf16(qp[ks], sf, qs0, 0, 0, 0);
        }
        WAVE_SYNC();
        {
          const float cs = Cs[fr];
          const float4 ct4 = *reinterpret_cast<const float4*>(Cs + fq * 4);
          const float4 bt4 = *reinterpret_cast<const float4*>(Bts + fq * 4);
          const float ctv[4] = {ct4.x, ct4.y, ct4.z, ct4.w}, btv[4] = {bt4.x, bt4.y, bt4.z, bt4.w};
#pragma unroll
          for (int i = 0; i < 4; ++i) {
            const int t = fq * 4 + i;
            const float e = __expf(fminf(ctv[i] - cs, 0.f));
            A1[t * 16 + fr] = (fr < t) ? btv[i] * g1[i] * e : 0.f;
            A2[t * 16 + fr] = (fr <= t) ? g2[i] * e : 0.f;
            KSs[t * 16 + fr] = ks0[i];
            QSs[t * 16 + fr] = qs0[i];
          }
        }
        WAVE_SYNC();
        float dreg[4] = {0.f, 0.f, 0.f, 0.f};
        float na1[4], na2[4], nbt, nec, nv, nks, nqs;
#pragma unroll
        for (int j = 0; j < 4; ++j) { na1[j] = A1[sq + 4 * j]; na2[j] = A2[sq + 4 * j]; }
        nbt = Bts[0]; nec = Ecs[0]; nv = Lv[tb * 68 + wid * 16 + vq]; nks = KSs[vq]; nqs = QSs[vq];
#pragma unroll
        for (int t = 0; t < 16; ++t) {
          float a1[4], a2[4];
#pragma unroll
          for (int j = 0; j < 4; ++j) { a1[j] = na1[j]; a2[j] = na2[j]; }
          const float bt = nbt, ec = nec, vv = nv, ksv = nks, qsv = nqs;
          if (t < 15) {
#pragma unroll
            for (int j = 0; j < (t + 4) / 4; ++j) na1[j] = A1[(t + 1) * 16 + sq + 4 * j];
#pragma unroll
            for (int j = 0; j <= ((t + 1) >> 2); ++j) na2[j] = A2[(t + 1) * 16 + sq + 4 * j];
            nbt = Bts[t + 1]; nec = Ecs[t + 1]; nv = Lv[(tb + t + 1) * 68 + wid * 16 + vq]; nks = KSs[(t + 1) * 16 + vq]; nqs = QSs[(t + 1) * 16 + vq];
          }
          float part = 0.f;
#pragma unroll
          for (int j = 0; j < (t + 3) / 4; ++j) part += a1[j] * dreg[j];
          part = reduce4(part);
          const float dt = bt * vv - bt * ec * ksv - part;
          dreg[t >> 2] = (sq == (t & 3)) ? dt : dreg[t >> 2];
          float po = 0.f;
#pragma unroll
          for (int j = 0; j <= (t >> 2); ++j) po += a2[j] * dreg[j];
          po = reduce4(po);
          Lo[(tb + t) * 64 + wid * 16 + vq] = ec * qsv + po;
          DlT[vq * 16 + t] = dt;
        }
        WAVE_SYNC();
        {
          const float Dd = Ecs[15];
          bf16x8 df = {0, 0, 0, 0, 0, 0, 0, 0};
          float4 e0 = make_float4(0.f, 0.f, 0.f, 0.f), e1 = e0;
          if (fq < 2) {
            const float4 x0 = *reinterpret_cast<const float4*>(DlT + fr * 16 + fq * 8), x1 = *reinterpret_cast<const float4*>(DlT + fr * 16 + fq * 8 + 4);
            const uint4 ux = make_uint4(pack2(x0.x, x0.y), pack2(x0.z, x0.w), pack2(x1.x, x1.y), pack2(x1.z, x1.w));
            df = __builtin_bit_cast(bf16x8, ux);
            e0 = *reinterpret_cast<const float4*>(E15 + fq * 8); e1 = *reinterpret_cast<const float4*>(E15 + fq * 8 + 4);
          }
#pragma unroll
          for (int mt = 0; mt < 4; ++mt) {
            bf16x8 kt = {0, 0, 0, 0, 0, 0, 0, 0};
            if (fq < 2) {
              const float4 x0 = *reinterpret_cast<const float4*>(LkT + (mt * 16 + fr) * 36 + tb + fq * 8), x1 = *reinterpret_cast<const float4*>(LkT + (mt * 16 + fr) * 36 + tb + fq * 8 + 4);
              const uint4 ux = make_uint4(pack2(x0.x * e0.x, x0.y * e0.y), pack2(x0.z * e0.z, x0.w * e0.w), pack2(x1.x * e1.x, x1.y * e1.y), pack2(x1.z * e1.z, x1.w * e1.w));
              kt = __builtin_bit_cast(bf16x8, ux);
            }
            f32x4 sc = Sacc[mt];
            sc[0] *= Dd; sc[1] *= Dd; sc[2] *= Dd; sc[3] *= Dd;
            Sacc[mt] = __builtin_amdgcn_mfma_f32_16x16x32_bf16(kt, df, sc, 0, 0, 0);
          }
        }
        WAVE_SYNC();
      }
    }
    }
    __syncthreads();
  }
  if (wid >= 4) write_out(NCH - 1);
}

constexpr int G4_TAB = 640;
constexpr int G4_ROWS = 3 * 32 * 68 + 64 * 36 + 64;
constexpr int G4_TABS = 2 * G4_TAB;
__device__ __forceinline__ void gdn_block4(const Params& p, int l, int b, int h, int dir, char* smem, bool ctx_out) {
  const int tid = tid_l(), lane = tid & 63, wid = tid >> 6;
  float* Lbase = reinterpret_cast<float*>(smem);
  float* Tab_base = Lbase + 3 * G4_ROWS;
  float* Lo_base = Tab_base + 2 * G4_TABS;
  float* Wsc = Lo_base + 4096;
  float* Lw = Wsc + 4 * 768;
  const u16* PB = reinterpret_cast<const u16*>(p.ws + OFF_PB);
  const float* AB = reinterpret_cast<const float*>(p.ws + OFF_AB);
  u16* O = reinterpret_cast<u16*>(p.ws + (dir ? OFF_OGB : OFF_OGF));
  const float Acoef = -__expf(p.in[21][l * 8 + dir * 4 + h]);
  const float dtb = p.in[22][l * 8 + dir * 4 + h];
  const int fr = lane & 15, fq = lane >> 4;
  __syncthreads();
  {
    const float* cw = p.in[20] + (size_t)l * 3 * 256 * 3;
    for (int e = tid; e < 576; e += NT) { const int x = e / 192, r = e - x * 192; Lw[e] = cw[(size_t)(x * 256 + h * 64) * 3 + r]; }
  }
  __syncthreads();
  f32x4 Sacc[4];
#pragma unroll
  for (int i = 0; i < 4; ++i) Sacc[i] = f32x4{0.f, 0.f, 0.f, 0.f};
  constexpr int NCH = (CTXL + SEQ) / 32;
  const int mprep = wid & 1;
  const int t2 = tid & 255, pj = t2 >> 3, oc = t2 & 7;
  uint4 rg[3][3];
  float ral = 0.f, rbl = 0.f;
  auto row_info = [&](int cc, int step, int& Ls, int& tpos) -> size_t {
    const int seg = cc >= CTXL / 32, c0 = seg ? cc - CTXL / 32 : cc;
    Ls = seg ? SEQ : CTXL;
    const int rowbase = seg ? b * SEQ : ML + b * CTXL;
    tpos = dir ? (Ls - 1 - (c0 * 32 + step)) : (c0 * 32 + step);
    return (size_t)(rowbase + tpos);
  };
  auto issue_loads = [&](int cc) {
    int Ls, tpos;
    const size_t row = row_info(cc, pj, Ls, tpos);
    const bool vm = tpos > 0, vp = tpos < Ls - 1;
#pragma unroll
    for (int x = 0; x < 3; ++x) {
      const u16* s0 = PB + row * PBW + (x == 0 ? PB_K : (x == 1 ? PB_V : PB_Q)) + h * 64 + oc * 8;
      rg[x][1] = *reinterpret_cast<const uint4*>(s0);
      rg[x][0] = make_uint4(0, 0, 0, 0); rg[x][2] = make_uint4(0, 0, 0, 0);
      if (vm) rg[x][0] = *reinterpret_cast<const uint4*>(s0 - PBW);
      if (vp) rg[x][2] = *reinterpret_cast<const uint4*>(s0 + PBW);
    }
    if (oc == 0) { ral = AB[row * 16 + dir * 4 + h]; rbl = AB[row * 16 + 8 + dir * 4 + h]; }
  };
  auto prep_rows = [&](int cc) {
    float* Lk = Lbase + (cc % 3) * G4_ROWS;
    float* Lq = Lk + 32 * 68;
    float* Lv = Lq + 32 * 68;
    float* LkT = Lv + 32 * 68;
    float* Gsr = LkT + 64 * 36;
    float* Btr = Gsr + 32;
#pragma unroll
    for (int x = 0; x < 3; ++x) {
      float y[8];
      float ss = 0.f;
      const unsigned am[4] = {rg[x][0].x, rg[x][0].y, rg[x][0].z, rg[x][0].w};
      const unsigned a0[4] = {rg[x][1].x, rg[x][1].y, rg[x][1].z, rg[x][1].w};
      const unsigned ap[4] = {rg[x][2].x, rg[x][2].y, rg[x][2].z, rg[x][2].w};
      const float4* wq = reinterpret_cast<const float4*>(Lw + x * 192 + oc * 24);
      float wv[24];
#pragma unroll
      for (int i = 0; i < 6; ++i) { const float4 t4 = wq[i]; wv[i * 4] = t4.x; wv[i * 4 + 1] = t4.y; wv[i * 4 + 2] = t4.z; wv[i * 4 + 3] = t4.w; }
#pragma unroll
      for (int e = 0; e < 8; ++e) {
        const float xm = (e & 1) ? hi2f(am[e >> 1]) : lo2f(am[e >> 1]);
        const float x0 = (e & 1) ? hi2f(a0[e >> 1]) : lo2f(a0[e >> 1]);
        const float xp = (e & 1) ? hi2f(ap[e >> 1]) : lo2f(ap[e >> 1]);
        float v = wv[e * 3 + 0] * xm + wv[e * 3 + 1] * x0 + wv[e * 3 + 2] * xp;
        v = silu_f(v);
        y[e] = v;
        ss += v * v;
      }
      if (x != 1) {
        ss = reduce8(ss);
        float sc = rsqrtf(ss + EPS);
        if (x == 2) sc *= 0.125f;
#pragma unroll
        for (int e = 0; e < 8; ++e) y[e] *= sc;
      }
      if (x == 0) {
#pragma unroll
        for (int e = 0; e < 8; ++e) LkT[(oc * 8 + e) * 36 + pj] = y[e];
      }
      float* dst = (x == 0 ? Lk : (x == 1 ? Lv : Lq)) + pj * 68 + oc * 8;
      *reinterpret_cast<float4*>(dst) = make_float4(y[0], y[1], y[2], y[3]);
      *reinterpret_cast<float4*>(dst + 4) = make_float4(y[4], y[5], y[6], y[7]);
    }
    if (oc == 0) { Gsr[pj] = Acoef * softplus_f(ral + dtb); Btr[pj] = sigm(rbl); }
  };
  auto build_tables = [&](int cc) {
    const float* Lk = Lbase + (cc % 3) * G4_ROWS;
    const float* Lq = Lk + 32 * 68;
    const float* Gsr = Lk + 3 * 32 * 68 + 64 * 36;
    const float* Btr = Gsr + 32;
    float* T = Tab_base + (cc & 1) * G4_TABS + mprep * G4_TAB;
    float* A1 = T; float* A2 = T + 256; float* Ecs = T + 512; float* E15 = T + 528; float* Bts = T + 544; float* Cs = T + 560;
    const int tb = mprep * 16, st = tb + fr;
    {
      float ct = 0.f, c15 = 0.f;
#pragma unroll
      for (int j = 0; j < 16; ++j) { const float gj = Gsr[tb + j]; c15 += gj; ct += (j <= fr) ? gj : 0.f; }
      if (lane < 16) { Cs[lane] = ct; Ecs[lane] = __expf(ct); E15[lane] = __expf(c15 - ct); Bts[lane] = Btr[tb + lane]; }
    }
    f32x4 g1 = f32x4{0.f, 0.f, 0.f, 0.f}, g2 = f32x4{0.f, 0.f, 0.f, 0.f};
#pragma unroll
    for (int ks = 0; ks < 2; ++ks) {
      const float* kr = Lk + st * 68 + ks * 32 + fq * 8;
      const float* qr = Lq + st * 68 + ks * 32 + fq * 8;
      const float4 a0 = *reinterpret_cast<const float4*>(kr), a1 = *reinterpret_cast<const float4*>(kr + 4);
      const float4 b0 = *reinterpret_cast<const float4*>(qr), b1 = *reinterpret_cast<const float4*>(qr + 4);
      const uint4 ua = make_uint4(pack2(a0.x, a0.y), pack2(a0.z, a0.w), pack2(a1.x, a1.y), pack2(a1.z, a1.w));
      const uint4 ub = make_uint4(pack2(b0.x, b0.y), pack2(b0.z, b0.w), pack2(b1.x, b1.y), pack2(b1.z, b1.w));
      const bf16x8 kf = __builtin_bit_cast(bf16x8, ua), qf = __builtin_bit_cast(bf16x8, ub);
      g1 = __builtin_amdgcn_mfma_f32_16x16x32_bf16(kf, kf, g1, 0, 0, 0);
      g2 = __builtin_amdgcn_mfma_f32_16x16x32_bf16(qf, kf, g2, 0, 0, 0);
    }
    WAVE_SYNC();
    {
      const float cs = Cs[fr];
      const float4 ct4 = *reinterpret_cast<const float4*>(Cs + fq * 4);
      const float4 bt4 = *reinterpret_cast<const float4*>(Bts + fq * 4);
      const float ctv[4] = {ct4.x, ct4.y, ct4.z, ct4.w}, btv[4] = {bt4.x, bt4.y, bt4.z, bt4.w};
#pragma unroll
      for (int i = 0; i < 4; ++i) {
        const int t = fq * 4 + i;
        const float e = __expf(fminf(ctv[i] - cs, 0.f));
        A1[t * 16 + fr] = (fr < t) ? btv[i] * g1[i] * e : 0.f;
        A2[t * 16 + fr] = (fr <= t) ? g2[i] * e : 0.f;
      }
    }
  };
  auto write_out = [&](int cc) {
    const int t3 = tid - 384, pj = t3 >> 2, oc4 = t3 & 3;
    int Ls, tpos;
    const size_t row = row_info(cc, pj, Ls, tpos);
    if (!((cc >= CTXL / 32) || ctx_out)) return;
    const float* s = Lo_base + (cc & 1) * 2048 + pj * 64 + oc4 * 16;
#pragma unroll
    for (int hh = 0; hh < 2; ++hh) {
      const float4 oa = *reinterpret_cast<const float4*>(s + hh * 8), ob = *reinterpret_cast<const float4*>(s + hh * 8 + 4);
      uint4 w; w.x = pack2(oa.x, oa.y); w.y = pack2(oa.z, oa.w); w.z = pack2(ob.x, ob.y); w.w = pack2(ob.z, ob.w);
      *reinterpret_cast<uint4*>(O + row * 256 + h * 64 + oc4 * 16 + hh * 8) = w;
    }
  };
  if (wid >= 4) { issue_loads(0); prep_rows(0); issue_loads(1); }
  __syncthreads();
  if (wid >= 4) { prep_rows(1); issue_loads(2); }
  if (wid == 4 || wid == 5) build_tables(0);
  __syncthreads();
#pragma unroll 1
  for (int cc = 0; cc < NCH; ++cc) {
    if (wid >= 4) {
      if (cc + 2 < NCH) { prep_rows(cc + 2); if (cc + 3 < NCH) issue_loads(cc + 3); }
      if (wid < 6) { if (cc + 1 < NCH) build_tables(cc + 1); }
      else { if (cc > 0) write_out(cc - 1); }
    } else {
      float* Lk = Lbase + (cc % 3) * G4_ROWS;
      float* Lq = Lk + 32 * 68;
      float* Lv = Lq + 32 * 68;
      const float* LkT = Lv + 32 * 68;
      float* Lo = Lo_base + (cc & 1) * 2048;
      float* KSs = Wsc + wid * 768; float* QSs = KSs + 256; float* DlT = KSs + 512;
      const int vq = lane >> 2, sq = lane & 3;
#pragma unroll 1
      for (int mc = 0; mc < 2; ++mc) {
        const int tb = mc * 16;
        const float* T = Tab_base + (cc & 1) * G4_TABS + mc * G4_TAB;
        const float* A1 = T; const float* A2 = T + 256; const float* Ecs = T + 512; const float* E15 = T + 528; const float* Bts = T + 544;
        f32x4 ks0 = f32x4{0.f, 0.f, 0.f, 0.f}, qs0 = f32x4{0.f, 0.f, 0.f, 0.f};
#pragma unroll
        for (int ks = 0; ks < 2; ++ks) {
          const float* kr = Lk + (tb + fr) * 68;
          const float* qr = Lq + (tb + fr) * 68;
          const float4 c0 = *reinterpret_cast<const float4*>(kr + (2 * ks) * 16 + fq * 4), c1 = *reinterpret_cast<const float4*>(kr + (2 * ks + 1) * 16 + fq * 4);
          const float4 d0 = *reinterpret_cast<const float4*>(qr + (2 * ks) * 16 + fq * 4), d1 = *reinterpret_cast<const float4*>(qr + (2 * ks + 1) * 16 + fq * 4);
          const uint4 uc = make_uint4(pack2(c0.x, c0.y), pack2(c0.z, c0.w), pack2(c1.x, c1.y), pack2(c1.z, c1.w));
          const uint4 ud = make_uint4(pack2(d0.x, d0.y), pack2(d0.z, d0.w), pack2(d1.x, d1.y), pack2(d1.z, d1.w));
          const uint4 us = make_uint4(pack2(Sacc[2 * ks][0], Sacc[2 * ks][1]), pack2(Sacc[2 * ks][2], Sacc[2 * ks][3]),
                                      pack2(Sacc[2 * ks + 1][0], Sacc[2 * ks + 1][1]), pack2(Sacc[2 * ks + 1][2], Sacc[2 * ks + 1][3]));
          const bf16x8 sf = __builtin_bit_cast(bf16x8, us);
          ks0 = __builtin_amdgcn_mfma_f32_16x16x32_bf16(__builtin_bit_cast(bf16x8, uc), sf, ks0, 0, 0, 0);
          qs0 = __builtin_amdgcn_mfma_f32_16x16x32_bf16(__builtin_bit_cast(bf16x8, ud), sf, qs0, 0, 0, 0);
        }
#pragma unroll
        for (int i = 0; i < 4; ++i) { KSs[(fq * 4 + i) * 16 + fr] = ks0[i]; QSs[(fq * 4 + i) * 16 + fr] = qs0[i]; }
        WAVE_SYNC();
        float dreg[4] = {0.f, 0.f, 0.f, 0.f};
        float na1[4], na2[4], nbt, nec, nv, nks, nqs;
#pragma unroll
        for (int j = 0; j < 4; ++j) { na1[j] = A1[sq + 4 * j]; na2[j] = A2[sq + 4 * j]; }
        nbt = Bts[0]; nec = Ecs[0]; nv = Lv[tb * 68 + wid * 16 + vq]; nks = KSs[vq]; nqs = QSs[vq];
#pragma unroll
        for (int t = 0; t < 16; ++t) {
          float a1[4], a2[4];
#pragma unroll
          for (int j = 0; j < 4; ++j) { a1[j] = na1[j]; a2[j] = na2[j]; }
          const float bt = nbt, ec = nec, vv = nv, ksv = nks, qsv = nqs;
          if (t < 15) {
#pragma unroll
            for (int j = 0; j < (t + 4) / 4; ++j) na1[j] = A1[(t + 1) * 16 + sq + 4 * j];
#pragma unroll
            for (int j = 0; j <= ((t + 1) >> 2); ++j) na2[j] = A2[(t + 1) * 16 + sq + 4 * j];
            nbt = Bts[t + 1]; nec = Ecs[t + 1]; nv = Lv[(tb + t + 1) * 68 + wid * 16 + vq]; nks = KSs[(t + 1) * 16 + vq]; nqs = QSs[(t + 1) * 16 + vq];
          }
          float part = 0.f;
#pragma unroll
          for (int j = 0; j < (t + 3) / 4; ++j) part += a1[j] * dreg[j];
          part = reduce4(part);
          const float dt = bt * vv - bt * ec * ksv - part;
          dreg[t >> 2] = (sq == (t & 3)) ? dt : dreg[t >> 2];
          float po = 0.f;
#pragma unroll
          for (int j = 0; j <= (t >> 2); ++j) po += a2[j] * dreg[j];
          po = reduce4(po);
          Lo[(tb + t) * 64 + wid * 16 + vq] = ec * qsv + po;
          DlT[vq * 16 + t] = dt;
        }
        WAVE_SYNC();
        {
          const float Dd = Ecs[15];
          bf16x8 df = {0, 0, 0, 0, 0, 0, 0, 0};
          float4 e0 = make_float4(0.f, 0.f, 0.f, 0.f), e1 = e0;
          if (fq < 2) {
            const float4 x0 = *reinterpret_cast<const float4*>(DlT + fr * 16 + fq * 8), x1 = *reinterpret_cast<const float4*>(DlT + fr * 16 + fq * 8 + 4);
            const uint4 ux = make_uint4(pack2(x0.x, x0.y), pack2(x0.z, x0.w), pack2(x1.x, x1.y), pack2(x1.z, x1.w));
            df = __builtin_bit_cast(bf16x8, ux);
            e0 = *reinterpret_cast<const float4*>(E15 + fq * 8); e1 = *reinterpret_cast<const float4*>(E15 + fq * 8 + 4);
          }
#pragma unroll
          for (int mt = 0; mt < 4; ++mt) {
            bf16x8 kt = {0, 0, 0, 0, 0, 0, 0, 0};
            if (fq < 2) {
              const float4 x0 = *reinterpret_cast<const float4*>(LkT + (mt * 16 + fr) * 36 + tb + fq * 8), x1 = *reinterpret_cast<const float4*>(LkT + (mt * 16 + fr) * 36 + tb + fq * 8 + 4);
              const uint4 ux = make_uint4(pack2(x0.x * e0.x, x0.y * e0.y), pack2(x0.z * e0.z, x0.w * e0.w), pack2(x1.x * e1.x, x1.y * e1.y), pack2(x1.z * e1.z, x1.w * e1.w));
              kt = __builtin_bit_cast(bf16x8, ux);
            }
            f32x4 sc = Sacc[mt];
            sc[0] *= Dd; sc[1] *= Dd; sc[2] *= Dd; sc[3] *= Dd;
            Sacc[mt] = __builtin_amdgcn_mfma_f32_16x16x32_bf16(kt, df, sc, 0, 0, 0);
          }
        }
        WAVE_SYNC();
      }
    }
    __syncthreads();
  }
  if (wid >= 6) write_out(NCH - 1);
}

__device__ __forceinline__ void s5_wave(const Params& p, int l, int b, int g, int dir, char* Lw, bool ctx_out) {
  const int lane = tid_l() & 63, fr = lane & 15, fq = lane >> 4;
  u16* Ubf = reinterpret_cast<u16*>(Lw);
  float* Bu = reinterpret_cast<float*>(Lw + 512);
  u16* Sbf = reinterpret_cast<u16*>(Lw + 512 + 8448);
  const u16* PB = reinterpret_cast<const u16*>(p.ws + OFF_PB);
  u16* O = reinterpret_cast<u16*>(p.ws + (dir ? OFF_O5B : OFF_O5F));
  const int gi = (l * 2 + dir) * 16 + g;
  const float dt = expf(p.in[11][gi]);
  float a_re, a_im;
  {
    const float lr = p.in[9][gi * 64 + lane], li = p.in[10][gi * 64 + lane];
    const float mag = expf(lr * dt);
    float sn, cs;
    sincosf(li * dt, &sn, &cs);
    a_re = mag * cs; a_im = mag * sn;
  }
  bf16x8 Af[8];
#pragma unroll
  for (int mt = 0; mt < 8; ++mt) {
    const int m = mt * 16 + fr, pp = m >> 1, ri = m & 1;
    bf16x8 v = {0, 0, 0, 0, 0, 0, 0, 0};
    if (fq < 2) {
      const float lr = p.in[9][gi * 64 + pp], li = p.in[10][gi * 64 + pp];
      const float mag = expf(lr * dt);
      float sn, cs;
      sincosf(li * dt, &sn, &cs);
      const float xr = mag * cs - 1.f, xi = mag * sn;
      const float den = lr * lr + li * li;
      const float cr = (xr * lr + xi * li) / den, ci = (xi * lr - xr * li) / den;
      const float4* brp = reinterpret_cast<const float4*>(p.in[12] + (size_t)(gi * 64 + pp) * 16 + fq * 8);
      const float4* bip = reinterpret_cast<const float4*>(p.in[13] + (size_t)(gi * 64 + pp) * 16 + fq * 8);
      const float4 r0 = brp[0], r1 = brp[1], i0 = bip[0], i1 = bip[1];
      const float br[8] = {r0.x, r0.y, r0.z, r0.w, r1.x, r1.y, r1.z, r1.w};
      const float bi[8] = {i0.x, i0.y, i0.z, i0.w, i1.x, i1.y, i1.z, i1.w};
#pragma unroll
      for (int e = 0; e < 8; ++e) {
        const float val = ri ? (cr * bi[e] + ci * br[e]) : (cr * br[e] - ci * bi[e]);
        v[e] = (short)f2bf(val);
      }
    }
    Af[mt] = v;
  }
  bf16x8 Cf[4];
#pragma unroll
  for (int ks = 0; ks < 4; ++ks) {
    const size_t ci = (size_t)(gi * 16 + fr) * 64 + ks * 16 + fq * 4;
    const float4 cre = *reinterpret_cast<const float4*>(p.in[14] + ci);
    const float4 cim = *reinterpret_cast<const float4*>(p.in[15] + ci);
    bf16x8 v;
    v[0] = (short)f2bf(cre.x); v[1] = (short)f2bf(-cim.x); v[2] = (short)f2bf(cre.y); v[3] = (short)f2bf(-cim.y);
    v[4] = (short)f2bf(cre.z); v[5] = (short)f2bf(-cim.z); v[6] = (short)f2bf(cre.w); v[7] = (short)f2bf(-cim.w);
    Cf[ks] = v;
  }
  float sr = 0.f, si = 0.f;
  constexpr int NCH = (CTXL + SEQ) / 16, NCC = CTXL / 16;
  auto row_of = [&](int cc, int j) -> size_t {
    const int seg = cc >= NCC, c0 = seg ? cc - NCC : cc;
    const int Ls = seg ? SEQ : CTXL, rowbase = seg ? b * SEQ : ML + b * CTXL;
    const int tpos = dir ? (Ls - 1 - (c0 * 16 + j)) : (c0 * 16 + j);
    return (size_t)(rowbase + tpos);
  };
  uint4 ureg = make_uint4(0, 0, 0, 0);
  if (fq < 2) ureg = *reinterpret_cast<const uint4*>(PB + row_of(0, fr) * PBW + g * 16 + fq * 8);
  auto readout = [&](int cc) {
    if (!((cc >= NCC) || ctx_out)) return;
    const u16* Sb = Sbf + (cc & 1) * 2176;
    f32x4 y = f32x4{0.f, 0.f, 0.f, 0.f};
#pragma unroll
    for (int ks = 0; ks < 4; ++ks) {
      const bf16x8 sa = *reinterpret_cast<const bf16x8*>(Sb + fr * 136 + ks * 32 + fq * 8);
      y = __builtin_amdgcn_mfma_f32_16x16x32_bf16(Cf[ks], sa, y, 0, 0, 0);
    }
    uint2 w;
    w.x = pack2(y[0], y[1]); w.y = pack2(y[2], y[3]);
    *reinterpret_cast<uint2*>(O + row_of(cc, fr) * 256 + g * 16 + fq * 4) = w;
  };
#pragma unroll 1
  for (int cc = 0; cc < NCH; ++cc) {
    const bf16x8 ub = __builtin_bit_cast(bf16x8, ureg);
    if (fq < 2 && cc + 1 < NCH) ureg = *reinterpret_cast<const uint4*>(PB + row_of(cc + 1, fr) * PBW + g * 16 + fq * 8);
#pragma unroll
    for (int mt = 0; mt < 8; ++mt) {
      const f32x4 r = __builtin_amdgcn_mfma_f32_16x16x32_bf16(Af[mt], ub, f32x4{0.f, 0.f, 0.f, 0.f}, 0, 0, 0);
      *reinterpret_cast<float4*>(Bu + fr * 132 + mt * 16 + fq * 4) = make_float4(r[0], r[1], r[2], r[3]);
    }
    WAVE_SYNC();
    float2 buv[16];
#pragma unroll
    for (int j = 0; j < 16; ++j) buv[j] = *reinterpret_cast<const float2*>(Bu + j * 132 + 2 * lane);
    if (cc > 0) readout(cc - 1);
    u16* Sc = Sbf + (cc & 1) * 2176;
#pragma unroll
    for (int j = 0; j < 16; ++j) {
      const float nr = fmaf(a_re, sr, fmaf(-a_im, si, buv[j].x));
      const float ni = fmaf(a_re, si, fmaf(a_im, sr, buv[j].y));
      sr = nr; si = ni;
      *reinterpret_cast<unsigned*>(Sc + j * 136 + 2 * lane) = pack2(sr, si);
    }
    WAVE_SYNC();
  }
  readout(NCH - 1);
}

__device__ __forceinline__ void sgu_item(const Params& p, int l, int rowbase, int g, char* smem) {
  const int tid = tid_l(), lane = tid & 63, wid = tid >> 6, fr = lane & 15, fq = lane >> 4;
  const u16* PB = reinterpret_cast<const u16*>(p.ws + OFF_PB);
  u16* Y = reinterpret_cast<u16*>(p.ws + OFF_Y);
  u16* vT = reinterpret_cast<u16*>(smem);
  u16 uraw[4][4];
#pragma unroll
  for (int n = 0; n < 4; ++n)
#pragma unroll
    for (int j = 0; j < 4; ++j)
      uraw[n][j] = PB[(size_t)(rowbase + wid * 16 + fq * 4 + j) * PBW + PB_USG + g * 64 + n * 16 + fr];
  __syncthreads();
  {
    const int q = tid >> 2, qt = tid & 3;
    const u16* src = PB + (size_t)(rowbase + q) * PBW + PB_VSG + g * 64 + qt * 16;
    float v[16];
    float s = 0.f;
#pragma unroll
    for (int i = 0; i < 2; ++i) {
      const uint4 r = *reinterpret_cast<const uint4*>(src + i * 8);
      const unsigned a[4] = {r.x, r.y, r.z, r.w};
#pragma unroll
      for (int e = 0; e < 4; ++e) {
        v[i * 8 + e * 2] = gelu_t(lo2f(a[e]));
        v[i * 8 + e * 2 + 1] = gelu_t(hi2f(a[e]));
        s += v[i * 8 + e * 2] + v[i * 8 + e * 2 + 1];
      }
    }
    s += __shfl_xor(s, 1);
    s += __shfl_xor(s, 2);
    const float mu = s * (1.f / 64.f);
    float vs = 0.f;
#pragma unroll
    for (int i = 0; i < 16; ++i) { const float d = v[i] - mu; vs += d * d; }
    vs += __shfl_xor(vs, 1);
    vs += __shfl_xor(vs, 2);
    const float rs = rsqrtf(vs * (1.f / 64.f) + EPS);
    const float* lg = p.in[24] + l * 256 + g * 64 + qt * 16;
    const float* lb = p.in[25] + l * 256 + g * 64 + qt * 16;
#pragma unroll
    for (int i = 0; i < 16; ++i) {
      const float o = (v[i] - mu) * rs * lg[i] + lb[i];
      vT[(qt * 16 + i) * 136 + q] = f2bf(o);
    }
  }
  __syncthreads();
  const u16* Wg = reinterpret_cast<const u16*>(p.ws + OFF_SGW) + (size_t)(l * 4 + g) * 128 * 128;
  f32x4 acc[4];
#pragma unroll
  for (int n = 0; n < 4; ++n) acc[n] = f32x4{0.f, 0.f, 0.f, 0.f};
#pragma unroll
  for (int ks = 0; ks < 4; ++ks) {
    const bf16x8 a = *reinterpret_cast<const bf16x8*>(Wg + (size_t)(wid * 16 + fr) * 128 + ks * 32 + fq * 8);
#pragma unroll
    for (int n = 0; n < 4; ++n) {
      const bf16x8 bb = *reinterpret_cast<const bf16x8*>(vT + (n * 16 + fr) * 136 + ks * 32 + fq * 8);
      acc[n] = __builtin_amdgcn_mfma_f32_16x16x32_bf16(a, bb, acc[n], 0, 0, 0);
    }
  }
  const float* sgb = p.in[27] + (size_t)(l * 4 + g) * 128;
#pragma unroll
  for (int n = 0; n < 4; ++n)
#pragma unroll
    for (int j = 0; j < 4; ++j) {
      const int pp = wid * 16 + fq * 4 + j, c = n * 16 + fr;
      const size_t row = (size_t)(rowbase + pp);
      const float u = gelu_t(bf2f(uraw[n][j]));
      Y[row * 1024 + 768 + g * 64 + c] = f2bf(u * (acc[n][j] + sgb[pp]));
    }
}

__device__ __forceinline__ void phase_mix(const Params& p, int l, char* smem) {
  const bool ctx_out = l < DEPTH - 1;
  u16* Y = reinterpret_cast<u16*>(p.ws + OFF_Y);
  {
    SchedStd S;
    S.init(8, 32, 4096, p.ws + OFF_DL, (size_t)256 * 4096 * 2, p.ws + OFF_FT, (size_t)256 * 4096 * 2);
    EpiFnet E; E.Y = Y; E.rowbase = 0; E.rows_per_b = SEQ;
    gemm_phase((PG8_LAS unsigned char*)(smem), 4096, 4096, S, E);
  }
  int* cnt = reinterpret_cast<int*>(p.ws + OFF_CNT) + l;
  volatile int* s_item = reinterpret_cast<volatile int*>(smem + SMALL_OFF);
  const int N_GDN = 256, N_S5 = 128, N_SL = 2048, N_SC = 256, N_FC = 64;
  const int total = N_GDN + N_S5 + N_SL + (ctx_out ? (N_SC + N_FC) : 0);
  for (;;) {
    const int tid = tid_l(), wid = tid >> 6;
    __syncthreads();
    if (tid == 0) *s_item = atomicAdd(cnt, 1);
    __syncthreads();
    int it = *s_item;
    if (it >= total) break;
    if (it < N_GDN) {
      gdn_block4(p, l, (it >> 2) & 31, it & 3, it >> 7, smem, ctx_out);
      continue;
    }
    it -= N_GDN;
    if (it < N_S5) {
      const int b8 = it & 3, g = (it >> 2) & 15, dir = it >> 6;
      s5_wave(p, l, b8 * 8 + wid, g, dir, smem + wid * 17664, ctx_out);
      continue;
    }
    it -= N_S5;
    if (it < N_SL) {
      const int g = it & 3, n = (it >> 2) & 15, b = it >> 6;
      sgu_item(p, l, b * SEQ + n * 128, g, smem);
      continue;
    }
    it -= N_SL;
    if (it < N_SC) {
      const int g = it & 3, n = (it >> 2) & 1, b = it >> 3;
      sgu_item(p, l, ML + b * CTXL + n * 128, g, smem);
      continue;
    }
    it -= N_SC;
    {
      const int grp = tid >> 8, t2 = tid & 255, lane = t2 & 63, w4 = t2 >> 6, wr = w4 >> 1, wc = w4 & 1, fr = lane & 15, fq = lane >> 4;
      const int b = it >> 1, mt = it & 1, nt = grp;
      f32x4 acc[4][4];
      zero_acc<4>(acc);
      gemm_tile<4>(reinterpret_cast<const u16*>(p.ws + OFF_DC) + (size_t)mt * 128 * 512, 512,
                   reinterpret_cast<const u16*>(p.ws + OFF_FTC) + (size_t)(b * 256 + nt * 128) * 512, 512, 512, acc, smem + grp * 32768);
#pragma unroll
      for (int m = 0; m < 4; ++m)
#pragma unroll
        for (int n = 0; n < 4; ++n)
#pragma unroll
          for (int j = 0; j < 4; ++j) {
            const size_t row = (size_t)ML + b * CTXL + mt * 128 + wr * 64 + m * 16 + fq * 4 + j;
            Y[row * 1024 + 256 + nt * 128 + wc * 64 + n * 16 + fr] = f2bf(acc[m][n][j]);
          }
    }
  }
}

__device__ __forceinline__ void phase_fin(const Params& p, int l, int Mrows, char* smem) {
  const int tid = tid_l(), lane = tid & 63, wid = tid >> 6, fr = lane & 15, fq = lane >> 4;
  const u16* PB = reinterpret_cast<const u16*>(p.ws + OFF_PB);
  const u16* O5F = reinterpret_cast<const u16*>(p.ws + OFF_O5F);
  const u16* O5B = reinterpret_cast<const u16*>(p.ws + OFF_O5B);
  const u16* OGF = reinterpret_cast<const u16*>(p.ws + OFF_OGF);
  const u16* OGB = reinterpret_cast<const u16*>(p.ws + OFF_OGB);
  u16* Y = reinterpret_cast<u16*>(p.ws + OFF_Y);
  const u16* GluT = reinterpret_cast<const u16*>(p.ws + OFF_W) + (size_t)l * LAYER_W + GLU_OFF;
  u16* Gs = reinterpret_cast<u16*>(smem);
  u16* At = reinterpret_cast<u16*>(smem) + 256 * 264;
  const float* gain = p.in[23] + l * 64;
  const float* dsk = p.in[16] + l * 256;
  const float* glb = p.in[18] + l * 256;
  __syncthreads();
  for (int e = tid; e < 256 * 32; e += NT) {
    const int n = e >> 5, c8 = (e & 31) * 8;
    *reinterpret_cast<uint4*>(Gs + n * 264 + c8) = *reinterpret_cast<const uint4*>(GluT + (size_t)n * 256 + c8);
  }
  const int items = Mrows / 32;
  uint2 gf[4], gb[4], gz[4], yf[4], yb[4], yu[4];
  auto load_item = [&](int it) {
    const int r0 = it * 32;
#pragma unroll
    for (int k = 0; k < 4; ++k) {
      const size_t row = (size_t)(r0 + wid + k * NW);
      gf[k] = *reinterpret_cast<const uint2*>(OGF + row * 256 + lane * 4);
      gb[k] = *reinterpret_cast<const uint2*>(OGB + row * 256 + lane * 4);
      gz[k] = *reinterpret_cast<const uint2*>(PB + row * PBW + PB_Z + lane * 4);
      const int e = tid + k * NT, rr = e >> 6, c4 = (e & 63) * 4;
      const size_t row2 = (size_t)(r0 + rr);
      yf[k] = *reinterpret_cast<const uint2*>(O5F + row2 * 256 + c4);
      yb[k] = *reinterpret_cast<const uint2*>(O5B + row2 * 256 + c4);
      yu[k] = *reinterpret_cast<const uint2*>(PB + row2 * PBW + c4);
    }
  };
  if ((int)blockIdx.x < items) load_item(blockIdx.x);
  for (int it = blockIdx.x; it < items; it += gridDim.x) {
    const int r0 = it * 32;
    __syncthreads();
#pragma unroll
    for (int k = 0; k < 4; ++k) {
      const size_t row = (size_t)(r0 + wid + k * NW);
      const uint2 f = gf[k], bq = gb[k], z = gz[k];
      float o[4] = {lo2f(f.x) + lo2f(bq.x), hi2f(f.x) + hi2f(bq.x), lo2f(f.y) + lo2f(bq.y), hi2f(f.y) + hi2f(bq.y)};
      float ss = o[0] * o[0] + o[1] * o[1] + o[2] * o[2] + o[3] * o[3];
      ss = reduce16(ss);
      const float rs = rsqrtf(ss * (1.f / 64.f) + EPS);
      const float4 gn = *reinterpret_cast<const float4*>(gain + (lane & 15) * 4);
      const float zz[4] = {lo2f(z.x), hi2f(z.x), lo2f(z.y), hi2f(z.y)};
      const float gg[4] = {gn.x, gn.y, gn.z, gn.w};
      float r[4];
#pragma unroll
      for (int i = 0; i < 4; ++i) r[i] = o[i] * rs * gg[i] * silu_f(zz[i]);
      uint2 w;
      w.x = pack2(r[0], r[1]); w.y = pack2(r[2], r[3]);
      *reinterpret_cast<uint2*>(Y + row * 1024 + 512 + lane * 4) = w;
    }
#pragma unroll
    for (int k = 0; k < 4; ++k) {
      const int e = tid + k * NT, rr = e >> 6, c4 = (e & 63) * 4;
      const uint2 f = yf[k], bq = yb[k], u = yu[k];
      const float4 d4 = *reinterpret_cast<const float4*>(dsk + c4);
      const float y0 = gelu_t(lo2f(f.x) + lo2f(bq.x) + d4.x * lo2f(u.x));
      const float y1 = gelu_t(hi2f(f.x) + hi2f(bq.x) + d4.y * hi2f(u.x));
      const float y2 = gelu_t(lo2f(f.y) + lo2f(bq.y) + d4.z * lo2f(u.y));
      const float y3 = gelu_t(hi2f(f.y) + hi2f(bq.y) + d4.w * hi2f(u.y));
      uint2 w;
      w.x = pack2(y0, y1); w.y = pack2(y2, y3);
      *reinterpret_cast<uint2*>(At + rr * 264 + c4) = w;
    }
    if (it + (int)gridDim.x < items) load_item(it + gridDim.x);
    __syncthreads();
    f32x4 acc[2][2];
#pragma unroll
    for (int m = 0; m < 2; ++m)
#pragma unroll
      for (int n = 0; n < 2; ++n) acc[m][n] = f32x4{0.f, 0.f, 0.f, 0.f};
#pragma unroll
    for (int ks = 0; ks < 8; ++ks) {
      bf16x8 a[2], g[2];
#pragma unroll
      for (int m = 0; m < 2; ++m) a[m] = *reinterpret_cast<const bf16x8*>(At + (m * 16 + fr) * 264 + ks * 32 + fq * 8);
#pragma unroll
      for (int n = 0; n < 2; ++n) g[n] = *reinterpret_cast<const bf16x8*>(Gs + (wid * 32 + n * 16 + fr) * 264 + ks * 32 + fq * 8);
#pragma unroll
      for (int m = 0; m < 2; ++m)
#pragma unroll
        for (int n = 0; n < 2; ++n) acc[m][n] = __builtin_amdgcn_mfma_f32_16x16x32_bf16(g[n], a[m], acc[m][n], 0, 0, 0);
    }
#pragma unroll
    for (int m = 0; m < 2; ++m)
#pragma unroll
      for (int n = 0; n < 2; ++n) {
        const int rr = m * 16 + fr, col = wid * 32 + n * 16 + fq * 4;
        const uint2 yv = *reinterpret_cast<const uint2*>(At + rr * 264 + col);
        const float4 b4 = *reinterpret_cast<const float4*>(glb + col);
        uint2 w;
        w.x = pack2(lo2f(yv.x) * sigm(acc[m][n][0] + b4.x), hi2f(yv.x) * sigm(acc[m][n][1] + b4.y));
        w.y = pack2(lo2f(yv.y) * sigm(acc[m][n][2] + b4.z), hi2f(yv.y) * sigm(acc[m][n][3] + b4.w));
        *reinterpret_cast<uint2*>(Y + (size_t)(r0 + rr) * 1024 + col) = w;
      }
  }
}

struct SchedGM {
  int nM, nsuper, G, c;
  const char* Y; const char* H; const char* Wb; const char* Wg;
  __device__ __forceinline__ bool next(int i, Unit& u) const {
    const int j = i >> 3, s = i & 7;
    const long L = (long)j * G + c;
    if (L >= nsuper) return false;
    int wgid = (int)L;
    { const int q = nsuper / G_NXCD, r = nsuper % G_NXCD, xcd = wgid % G_NXCD, off = wgid / G_NXCD; wgid = (xcd < r ? xcd * (q + 1) : r * (q + 1) + (xcd - r) * q) + off; }
    const int nig = G_WGM * 4, gid = wgid / nig, fm = gid * G_WGM, gsz = (nM - fm) < G_WGM ? (nM - fm) : G_WGM;
    u.pm = fm + ((wgid % nig) % gsz);
    u.pn = ((wgid % nig) / gsz) * 8 + s;
    return true;
  }
  __device__ __forceinline__ const char* aptr(const Unit& u) const {
    const int s = u.pn & 7;
    return (s < 4) ? Y + (size_t)u.pm * (256 * 1024 * 2) + s * 512 : H + (size_t)u.pm * (256 * 1024 * 2);
  }
  __device__ __forceinline__ const char* bptr(const Unit& u) const {
    const int s = u.pn & 7, dq = u.pn >> 3;
    return (s < 4) ? Wb + (size_t)dq * (256 * 1024 * 2) + s * 512 : Wg + (size_t)(dq * 4 + (s - 4)) * (256 * 1024 * 2);
  }
  __device__ __forceinline__ int kt(const Unit& u) const { return ((u.pn & 7) < 4) ? 4 : 16; }
};
struct EpiGM {
  uint4* brs;
  u16* ACC;
  __device__ __forceinline__ void operator()(const f32x4 (&acc)[2][2][4][2], const Unit& u, int wr, int wc, int fr, int fq) const {
    const int s = u.pn & 7, dq = u.pn >> 3;
    const int tid = tid_l();
    if (s < 4) {
#pragma unroll
      for (int ai = 0; ai < 2; ++ai)
#pragma unroll
        for (int bj = 0; bj < 2; ++bj)
#pragma unroll
          for (int m = 0; m < 4; ++m) {
            uint4 w;
            w.x = pack2(acc[ai][bj][m][0][0], acc[ai][bj][m][0][1]); w.y = pack2(acc[ai][bj][m][0][2], acc[ai][bj][m][0][3]);
            w.z = pack2(acc[ai][bj][m][1][0], acc[ai][bj][m][1][1]); w.w = pack2(acc[ai][bj][m][1][2], acc[ai][bj][m][1][3]);
            brs[(size_t)(s * 16 + (ai * 2 + bj) * 4 + m) * 512 + tid] = w;
          }
    } else {
      const int q = s - 4, bjq = q >> 1, nq = q & 1;
#pragma unroll
      for (int ai = 0; ai < 2; ++ai)
#pragma unroll
        for (int m = 0; m < 4; ++m) {
          float o[4] = {0.f, 0.f, 0.f, 0.f};
#pragma unroll
          for (int bj = 0; bj < 2; ++bj)
#pragma unroll
            for (int n = 0; n < 2; ++n) {
              const int ib = 2 * bj + n;
              const uint2 b2 = *(reinterpret_cast<const uint2*>(brs + (size_t)(ib * 16 + (ai * 2 + bjq) * 4 + m) * 512 + tid) + nq);
              const f32x4 g = acc[ai][bj][m][n];
              o[0] += sigm(g[0]) * lo2f(b2.x); o[1] += sigm(g[1]) * hi2f(b2.x);
              o[2] += sigm(g[2]) * lo2f(b2.y); o[3] += sigm(g[3]) * hi2f(b2.y);
            }
          const int r = u.pm * 256 + ai * 128 + wr * 64 + m * 16 + fr;
          const int d = dq * 256 + 64 * q + 16 * wc + 4 * fq;
          uint2 w; w.x = pack2(o[0], o[1]); w.y = pack2(o[2], o[3]);
          *reinterpret_cast<uint2*>(ACC + (size_t)r * 1024 + d) = w;
        }
    }
  }
};
__device__ __forceinline__ void phase_gm(const Params& p, int l, int Mrows, char* smem) {
  const u16* Wl = reinterpret_cast<const u16*>(p.ws + OFF_W) + (size_t)l * LAYER_W;
  SchedGM S;
  S.nM = Mrows / 256; S.nsuper = S.nM * 4; S.G = gridDim.x; S.c = blockIdx.x;
  S.Y = reinterpret_cast<const char*>(p.ws + OFF_Y);
  S.H = reinterpret_cast<const char*>(p.ws + OFF_H);
  S.Wb = reinterpret_cast<const char*>(Wl + WB_OFF);
  S.Wg = reinterpret_cast<const char*>(Wl + WG_OFF);
  EpiGM E;
  E.brs = reinterpret_cast<uint4*>(p.ws + OFF_BRS + (size_t)blockIdx.x * 524288);
  E.ACC = reinterpret_cast<u16*>(p.ws + OFF_ACC);
  gemm_phase((PG8_LAS unsigned char*)(smem), 1024, 1024, S, E);
}

__device__ __forceinline__ void phase_res(const Params& p, int l, int Mrows, const u16* A, int K, const u16* Bt, int gate_off, bool first, char* smem) {
  EpiRes E;
  E.xin_l = first ? p.in[0] : p.out;
  E.xin_c = first ? p.in[2] : reinterpret_cast<const float*>(p.ws + OFF_XC);
  E.xout_l = p.out;
  E.xout_c = reinterpret_cast<float*>(p.ws + OFF_XC);
  E.mod = reinterpret_cast<const float*>(p.ws + OFF_MOD) + (size_t)l * 33 * 6144;
  E.gate_off = gate_off;
  SchedStd S;
  S.init(Mrows / 256, 4, K, A, (size_t)256 * K * 2, Bt, (size_t)256 * K * 2);
  gemm_phase((PG8_LAS unsigned char*)(smem), K, K, S, E);
}

__device__ __forceinline__ void phase_ffn1(const Params& p, int l, int Mrows, char* smem) {
  const u16* H = reinterpret_cast<const u16*>(p.ws + OFF_H);
  const u16* W1T = reinterpret_cast<const u16*>(p.ws + OFF_W) + (size_t)l * LAYER_W + W1_OFF;
  EpiFfn1 E;
  E.HID = reinterpret_cast<u16*>(p.ws + OFF_HID);
  SchedStd S;
  S.init(Mrows / 256, 22, 1024, H, (size_t)256 * 1024 * 2, W1T, (size_t)256 * 1024 * 2);
  gemm_phase((PG8_LAS unsigned char*)(smem), 1024, 1024, S, E);
}

__device__ __forceinline__ void phase_final(const Params& p) {
  const int tid = tid_l();
  const int lane = tid & 63;
  const int gw = blockIdx.x * NW + (tid >> 6), tw = gridDim.x * NW;
  const float* nw = p.in[32];
  for (int r = gw; r < ML; r += tw) {
    float* xr = p.out + (size_t)r * 1024;
    float4 v[4];
    float ss = 0.f;
#pragma unroll
    for (int i = 0; i < 4; ++i) {
      v[i] = *reinterpret_cast<const float4*>(xr + i * 256 + lane * 4);
      ss += v[i].x * v[i].x + v[i].y * v[i].y + v[i].z * v[i].z + v[i].w * v[i].w;
    }
#pragma unroll
    for (int o = 32; o >= 1; o >>= 1) ss += __shfl_xor(ss, o);
    const float rs = rsqrtf(ss * (1.f / 1024.f) + EPS);
#pragma unroll
    for (int i = 0; i < 4; ++i) {
      const float4 g = *reinterpret_cast<const float4*>(nw + i * 256 + lane * 4);
      float4 o;
      o.x = v[i].x * rs * g.x; o.y = v[i].y * rs * g.y; o.z = v[i].z * rs * g.z; o.w = v[i].w * rs * g.w;
      *reinterpret_cast<float4*>(xr + i * 256 + lane * 4) = o;
    }
  }
}

__global__ void __launch_bounds__(NT, 2) mega(Params p) {
  cg::grid_group grid = cg::this_grid();
  extern __shared__ __attribute__((aligned(16))) unsigned char dsm[];
  char* smem = reinterpret_cast<char*>(dsm);
  volatile __attribute__((address_space(3))) unsigned* xst = (volatile __attribute__((address_space(3))) unsigned*)(dsm + SMALL_OFF + 16);
  if (threadIdx.x == 0) { xst[0] = 0u; xst[1] = 0u; }
  __syncthreads();
  const XcdBarrier xb = xcd_barrier_post(reinterpret_cast<unsigned*>(p.ws + OFF_BAR), xst);
  phase0(p, smem);
  grid.sync();
  mod_combine(p);
  xcd_barrier(xb);
  const u16* Wall = reinterpret_cast<const u16*>(p.ws + OFF_W);
#pragma unroll 1
  for (int l = 0; l < DEPTH; ++l) {
    const int Mpost = (l < DEPTH - 1) ? MT : ML;
    const u16* Wl = Wall + (size_t)l * LAYER_W;
    phase_norm(p, l, 0, MT);
    xcd_barrier(xb);
    phase_proj(p, l, smem);
    xcd_barrier(xb);
    phase_mix(p, l, smem);
    xcd_barrier(xb);
    phase_fin(p, l, Mpost, smem);
    xcd_barrier(xb);
    phase_gm(p, l, Mpost, smem);
    xcd_barrier(xb);
    phase_res(p, l, Mpost, reinterpret_cast<const u16*>(p.ws + OFF_ACC), 1024, Wl + WO_OFF, 2048, l == 0, smem);
    xcd_barrier(xb);
    phase_norm(p, l, 1, Mpost);
    xcd_barrier(xb);
    phase_ffn1(p, l, Mpost, smem);
    xcd_barrier(xb);
    phase_res(p, l, Mpost, reinterpret_cast<const u16*>(p.ws + OFF_HID), DFF, Wl + W2_OFF, 5120, false, smem);
    xcd_barrier(xb);
  }
  phase_final(p);
}

extern "C" void kernel_launch(void* const* d_in, const int* in_sizes, int n_in, void* d_out, int out_size,
                              void* d_ws, size_t ws_size, hipStream_t stream) {
  static int grid_blocks = 0;
  if (!grid_blocks) {
    int dev = 0, cus = 0, per_cu = 0;
    (void)hipGetDevice(&dev);
    (void)hipDeviceGetAttribute(&cus, hipDeviceAttributeMultiprocessorCount, dev);
    (void)hipFuncSetAttribute((const void*)mega, hipFuncAttributeMaxDynamicSharedMemorySize, DSM_BYTES);
    (void)hipOccupancyMaxActiveBlocksPerMultiprocessor(&per_cu, mega, NT, DSM_BYTES);
    if (per_cu < 1) per_cu = 1;
    if (per_cu > 1) per_cu = 1;
    grid_blocks = cus * per_cu;
    grid_blocks &= ~7;
    if (ws_size < WS_END) fprintf(stderr, "workspace too small: %zu < %zu\n", ws_size, (size_t)WS_END);
  }
  Params p{};
  for (int i = 0; i < 33; ++i) p.in[i] = (const float*)d_in[i];
  p.out = (float*)d_out;
  p.ws = (char*)d_ws;
  void* args[] = {&p};
  (void)hipMemsetAsync((char*)d_ws + OFF_CNT, 0, (OFF_BAR - OFF_CNT) + 3456 * 4, stream);
  hipError_t e = hipLaunchCooperativeKernel((void*)mega, dim3(grid_blocks), dim3(NT), args, DSM_BYTES, stream);
  if (e != hipSuccess) fprintf(stderr, "cooperative launch failed: %s (grid %d)\n", hipGetErrorString(e), grid_blocks);
}
```

```cpp
#include <hip/hip_runtime.h>
#include <hip/hip_cooperative_groups.h>
#include <cstdio>
namespace cg = cooperative_groups;

typedef unsigned short u16;
using bf16x8 = __attribute__((ext_vector_type(8))) short;
using f32x4 = __attribute__((ext_vector_type(4))) float;

#define NT 512
#define NW 8

constexpr int BATCH = 32, SEQ = 2048, CTXL = 256, DM = 1024, DEPTH = 4;
constexpr int ML = BATCH * SEQ;
constexpr int MC = BATCH * CTXL;
constexpr int MT = ML + MC;
constexpr int DIN = 6160, DFF = 2816;
constexpr int NPROJ = 2304;
constexpr int PBW = 1792;
constexpr int PB_K = 256, PB_V = 512, PB_Q = 768, PB_Z = 1024, PB_USG = 1280, PB_VSG = 1536;
constexpr float EPS = 1e-6f;

constexpr size_t WIN_OFF = 0;
constexpr size_t WG_OFF = WIN_OFF + (size_t)NPROJ * 1024;
constexpr size_t WB_OFF = WG_OFF + (size_t)4096 * 1024;
constexpr size_t WO_OFF = WB_OFF + (size_t)1024 * 1024;
constexpr size_t W1_OFF = WO_OFF + (size_t)1024 * 1024;
constexpr size_t W2_OFF = W1_OFF + (size_t)5632 * 1024;
constexpr size_t GLU_OFF = W2_OFF + (size_t)1024 * DFF;
constexpr size_t LAYER_W = GLU_OFF + 65536;

constexpr size_t al256(size_t x) { return (x + 255) & ~(size_t)255; }
constexpr size_t OFF_W = 0;
constexpr size_t OFF_SGW = al256(OFF_W + 4 * LAYER_W * 2);
constexpr size_t OFF_DL = al256(OFF_SGW + (size_t)4 * 4 * 128 * 128 * 2);
constexpr size_t OFF_DC = al256(OFF_DL + (size_t)2048 * 4096 * 2);
constexpr size_t OFF_MOD = al256(OFF_DC + (size_t)256 * 512 * 2);
constexpr size_t OFF_CNT = al256(OFF_MOD + (size_t)4 * 33 * 6144 * 4);
constexpr size_t OFF_BAR = al256(OFF_CNT + 256);
constexpr size_t OFF_XC = al256(OFF_BAR + 3456 * 4);
constexpr size_t OFF_H = al256(OFF_XC + (size_t)MC * 1024 * 4);
constexpr size_t OFF_PB = al256(OFF_H + (size_t)MT * 1024 * 2);
constexpr size_t OFF_FT = al256(OFF_PB + (size_t)MT * PBW * 2);
constexpr size_t OFF_FTC = al256(OFF_FT + (size_t)32 * 256 * 4096 * 2);
constexpr size_t OFF_AB = al256(OFF_FTC + (size_t)32 * 256 * 512 * 2);
constexpr size_t OFF_O5F = al256(OFF_AB + (size_t)MT * 16 * 4);
constexpr size_t OFF_O5B = al256(OFF_O5F + (size_t)MT * 256 * 2);
constexpr size_t OFF_OGF = al256(OFF_O5B + (size_t)MT * 256 * 2);
constexpr size_t OFF_OGB = al256(OFF_OGF + (size_t)MT * 256 * 2);
constexpr size_t OFF_Y = al256(OFF_OGB + (size_t)MT * 256 * 2);
constexpr size_t WS_END = al256(OFF_Y + (size_t)MT * 1024 * 2);
constexpr size_t OFF_ACC = OFF_PB;
constexpr size_t OFF_BRS = al256(OFF_PB + (size_t)MT * 1024 * 2);
static_assert(OFF_BRS + (size_t)256 * 524288 <= OFF_AB, "BRS alias too small");
constexpr size_t OFF_HID = OFF_PB;
static_assert(OFF_HID + (size_t)MT * DFF * 2 <= WS_END, "HID alias too small");

constexpr int STAGE_BYTES = 131072;
constexpr int SMALL_OFF = 152064;
constexpr int DSM_BYTES = SMALL_OFF + 256;

struct Params {
  const float* in[33];
  float* out;
  char* ws;
};

typedef __bf16 bf16x2_t __attribute__((ext_vector_type(2)));
__device__ __forceinline__ unsigned pack2(float a, float b) { bf16x2_t v = {(__bf16)a, (__bf16)b}; return __builtin_bit_cast(unsigned, v); }
__device__ __forceinline__ u16 f2bf(float f) { return __builtin_bit_cast(u16, (__bf16)f); }
__device__ __forceinline__ float bf2f(u16 h) { return __uint_as_float(((unsigned)h) << 16); }
__device__ __forceinline__ float lo2f(unsigned w) { return __uint_as_float(w << 16); }
__device__ __forceinline__ float hi2f(unsigned w) { return __uint_as_float(w & 0xffff0000u); }
__device__ __forceinline__ float sigm(float x) { return __builtin_amdgcn_rcpf(1.f + __expf(-x)); }
__device__ __forceinline__ float silu_f(float x) { return x * sigm(x); }
__device__ __forceinline__ float gelu_t(float x) { return x * sigm(1.5957691216057308f * (x + 0.044715f * x * x * x)); }
__device__ __forceinline__ float softplus_f(float x) { return x > 20.f ? x : log1pf(__expf(x)); }

__device__ __forceinline__ int tid_l() { int t = threadIdx.x; asm volatile("" : "+v"(t)); return t; }
#define WAVE_SYNC() do { __builtin_amdgcn_fence(__ATOMIC_SEQ_CST, "wavefront"); __builtin_amdgcn_wave_barrier(); } while (0)

#define XB_TMO      128
#define XB_XCNT(j)  (256  + 64 * (j))
#define XB_XSUB(j)  (1280 + 64 * (j))
#define XB_XGEN(j)  (2304 + 64 * (j))
#define XB_TOP      3328
#define XB_TOPGEN   3392
#define XCD_BAR_WORDS 3456
#define XB_SPIN_CAP (1u << 18)
__device__ __forceinline__ unsigned xb_ld(unsigned* p)              { return __hip_atomic_load(p, __ATOMIC_RELAXED, __HIP_MEMORY_SCOPE_AGENT); }
__device__ __forceinline__ unsigned xb_add(unsigned* p, unsigned v) { return __hip_atomic_fetch_add(p, v, __ATOMIC_RELAXED, __HIP_MEMORY_SCOPE_AGENT); }
__device__ __forceinline__ unsigned xb_xcc_id() { return (unsigned)__builtin_amdgcn_s_getreg((3 << 11) | 20) & 0xFu; }
#define XB_SPIN(cond, bar) do { unsigned _sp = 0; while (cond) { __builtin_amdgcn_s_sleep(1); \
    if ((++_sp & 255u) == 0u) { if (xb_ld(&(bar)[XB_TMO])) break; if (_sp > XB_SPIN_CAP) { atomicAdd(&(bar)[XB_TMO], 1u); break; } } } } while (0)
struct XcdBarrier { unsigned* bar; unsigned x; volatile __attribute__((address_space(3))) unsigned* st; };
__device__ __forceinline__ XcdBarrier xcd_barrier_post(unsigned* bar, volatile __attribute__((address_space(3))) unsigned* st) {
  XcdBarrier b; b.bar = bar; b.x = xb_xcc_id(); b.st = st;
  if (threadIdx.x == 0) (void)xb_add(&bar[XB_XCNT(b.x)], 1u);
  return b;
}
__device__ __forceinline__ void xcd_barrier_complete(unsigned* bar, unsigned x, unsigned& nloc, unsigned& nx) {
  const unsigned G = gridDim.x * gridDim.y * gridDim.z;
  unsigned sum, cnt, mine, sp = 0u;
  for (;;) {
    sum = 0u; cnt = 0u; mine = 0u;
#pragma unroll
    for (unsigned j = 0; j < 16; ++j) { const unsigned c = xb_ld(&bar[XB_XCNT(j)]); sum += c; cnt += (c > 0u) ? 1u : 0u; mine = (j == x) ? c : mine; }
    if (sum == G) break;
    __builtin_amdgcn_s_sleep(1);
    if ((++sp & 255u) == 0u) { if (xb_ld(&bar[XB_TMO])) break; if (sp > XB_SPIN_CAP) { atomicAdd(&bar[XB_TMO], 1u); break; } }
  }
  nloc = mine > 0u ? mine : 1u; nx = cnt > 0u ? cnt : 1u;
}
__device__ __forceinline__ void xcd_barrier(const XcdBarrier& b0) {
  asm volatile("s_waitcnt vmcnt(0)" ::: "memory");
  __syncthreads();
  if (threadIdx.x == 0) {
    XcdBarrier b = b0;
    { unsigned xs = xb_xcc_id(); asm volatile("" : "+s"(xs)); b.x = xs; }
    unsigned* bar = b.bar;
    __builtin_amdgcn_s_waitcnt(0);
    unsigned nloc = b.st[0], nx = b.st[1];
    if (nloc == 0u) { xcd_barrier_complete(bar, b.x, nloc, nx); b.st[0] = nloc; b.st[1] = nx; }
    const unsigned old = xb_add(&bar[XB_XSUB(b.x)], 1u);
    const unsigned gen = old / nloc;
    if (old + 1u == (gen + 1u) * nloc) {
      __builtin_amdgcn_fence(__ATOMIC_RELEASE, "agent");
      asm volatile("s_waitcnt vmcnt(0)" ::: "memory");
      const unsigned og = xb_add(&bar[XB_TOP], 1u);
      const unsigned tg = og / nx;
      if (og + 1u == (tg + 1u) * nx) xb_add(&bar[XB_TOPGEN], 1u);
      else XB_SPIN(xb_ld(&bar[XB_TOPGEN]) == tg, bar);
      __builtin_amdgcn_fence(__ATOMIC_ACQUIRE, "agent");
      xb_add(&bar[XB_XGEN(b.x)], 1u);
      asm volatile("s_waitcnt vmcnt(0)" ::: "memory");
    } else {
      XB_SPIN(xb_ld(&bar[XB_XGEN(b.x)]) == gen, bar);
      __builtin_amdgcn_fence(__ATOMIC_ACQUIRE, "agent");
      asm volatile("s_waitcnt vmcnt(0)" ::: "memory");
    }
  }
  __syncthreads();
}

template <int CTRL>
__device__ __forceinline__ float dpp_f(float x) {
  return __int_as_float(__builtin_amdgcn_update_dpp(0, __float_as_int(x), CTRL, 0xF, 0xF, true));
}
__device__ __forceinline__ float reduce4(float x) {
  x += dpp_f<0xB1>(x);
  x += dpp_f<0x4E>(x);
  return x;
}
__device__ __forceinline__ float reduce16(float x) {
  x += dpp_f<0xB1>(x);
  x += dpp_f<0x4E>(x);
  x += dpp_f<0x141>(x);
  x += dpp_f<0x140>(x);
  return x;
}
__device__ __forceinline__ float reduce8(float x) {
  x += dpp_f<0xB1>(x);
  x += dpp_f<0x4E>(x);
  x += dpp_f<0x141>(x);
  return x;
}
__device__ __forceinline__ bool tile_map(int t, int nM, int nN, int& mt, int& nt) {
  const int total = nM * nN;
  const int chunk = (total + 7) >> 3;
  const int q = (t & 7) * chunk + (t >> 3);
  if ((t >> 3) >= chunk || q >= total) return false;
  const int per = 8 * nN;
  const int grp = q / per, r = q - grp * per;
  mt = grp * 8 + (r & 7);
  nt = r >> 3;
  return true;
}
__device__ __forceinline__ int tile_iters(int nM, int nN) { return 8 * ((nM * nN + 7) >> 3); }

template <int NB>
__device__ __forceinline__ void gemm_tile(const u16* __restrict__ A, long lda, const u16* __restrict__ B, long ldb,
                                          int K, f32x4 (&acc)[4][NB], char* smem) {
  const int tid = tid_l() & 255, lane = tid & 63, wid = tid >> 6, wr = wid >> 1, wc = wid & 1, fr = lane & 15, fq = lane >> 4;
  const int nt = K >> 5;
  __syncthreads();
  auto stage = [&](int kt, int buf) {
#pragma unroll
    for (int i = 0; i < 2; ++i) {
      const int bo = tid * 16 + i * 4096;
      const int r = bo >> 6, c = (bo & 63) >> 1;
      __builtin_amdgcn_global_load_lds((const unsigned*)(A + (long)r * lda + kt * 32 + c),
                                       (unsigned*)(smem + buf * 16384 + bo), 16, 0, 0);
      if (i < NB / 2)
        __builtin_amdgcn_global_load_lds((const unsigned*)(B + (long)r * ldb + kt * 32 + c),
                                         (unsigned*)(smem + buf * 16384 + 8192 + bo), 16, 0, 0);
    }
  };
  stage(0, 0);
#pragma unroll 1
  for (int t = 0; t < nt; ++t) {
    asm volatile("s_waitcnt vmcnt(0)" ::: "memory");
    __syncthreads();
    if (t + 1 < nt) stage(t + 1, (t + 1) & 1);
    const char* sa = smem + (t & 1) * 16384;
    const char* sb = sa + 8192;
    bf16x8 a[4], b[NB];
#pragma unroll
    for (int m = 0; m < 4; ++m) a[m] = *reinterpret_cast<const bf16x8*>(sa + (wr * 64 + m * 16 + fr) * 64 + fq * 16);
#pragma unroll
    for (int n = 0; n < NB; ++n) b[n] = *reinterpret_cast<const bf16x8*>(sb + (wc * (NB * 16) + n * 16 + fr) * 64 + fq * 16);
    asm volatile("s_waitcnt lgkmcnt(0)" ::: "memory");
    __builtin_amdgcn_sched_barrier(0);
#pragma unroll
    for (int m = 0; m < 4; ++m)
#pragma unroll
      for (int n = 0; n < NB; ++n)
        acc[m][n] = __builtin_amdgcn_mfma_f32_16x16x32_bf16(a[m], b[n], acc[m][n], 0, 0, 0);
  }
}

template <int NB>
__device__ __forceinline__ void zero_acc(f32x4 (&acc)[4][NB]) {
#pragma unroll
  for (int m = 0; m < 4; ++m)
#pragma unroll
    for (int n = 0; n < NB; ++n) acc[m][n] = f32x4{0.f, 0.f, 0.f, 0.f};
}

#define PG8_LAS __attribute__((address_space(3)))
constexpr int G_BK = 64, G_HALF = 128, G_HTB = G_HALF * G_BK * 2, G_NXCD = 8, G_WGM = 8;
__device__ __forceinline__ int lds_byte(int r, int c) { const int st = (r >> 4) * 2 + (c >> 5), rr = r & 15, cc = c & 31, ob = rr * 64 + cc * 2; return st * 1024 + (ob ^ (((ob >> 9) & 1) << 5)); }
__device__ __forceinline__ void stage_rc(int b, int& R, int& C) { const int st = b / 1024, sb = b % 1024, swz = sb ^ (((sb >> 9) & 1) << 5); R = (st >> 1) * 16 + swz / 64; C = (st & 1) * 32 + (swz % 64) / 2; }
struct Unit { int pm, pn; };

struct SchedStd {
  int nM, nN, nwg, G, c, ktiles;
  const char* A; const char* B; size_t tA, tB;
  __device__ __forceinline__ void init(int nM_, int nN_, int K_, const void* A_, size_t tA_, const void* B_, size_t tB_) {
    nM = nM_; nN = nN_; nwg = nM * nN; G = gridDim.x; c = blockIdx.x; ktiles = K_ / G_BK; A = (const char*)A_; B = (const char*)B_; tA = tA_; tB = tB_;
  }
  __device__ __forceinline__ int kt(const Unit&) const { return ktiles; }
  __device__ __forceinline__ bool next(int i, Unit& u) const {
    const long L = (long)i * G + c;
    if (L >= nwg) return false;
    int wgid = (int)L;
    { const int q = nwg / G_NXCD, r = nwg % G_NXCD, xcd = wgid % G_NXCD, off = wgid / G_NXCD; wgid = (xcd < r ? xcd * (q + 1) : r * (q + 1) + (xcd - r) * q) + off; }
    const int nig = G_WGM * nN, gid = wgid / nig, fm = gid * G_WGM, gsz = (nM - fm) < G_WGM ? (nM - fm) : G_WGM;
    u.pm = fm + ((wgid % nig) % gsz); u.pn = (wgid % nig) / gsz;
    return true;
  }
  __device__ __forceinline__ const char* aptr(const Unit& u) const { return A + (size_t)u.pm * tA; }
  __device__ __forceinline__ const char* bptr(const Unit& u) const { return B + (size_t)u.pn * tB; }
};
struct SchedProjLast {
  SchedStd s;
  __device__ __forceinline__ bool next(int i, Unit& u) const {
    if (s.next(i, u)) return true;
    const long L = (long)i * s.G + s.c - s.nwg;
    if (L < 0 || L >= 128) return false;
    const int k = (int)L & 3;
    u.pm = 256 + ((int)L >> 2); u.pn = (k == 3) ? 7 : k;
    return true;
  }
  __device__ __forceinline__ const char* aptr(const Unit& u) const { return s.aptr(u); }
  __device__ __forceinline__ const char* bptr(const Unit& u) const { return s.bptr(u); }
  __device__ __forceinline__ int kt(const Unit&) const { return s.ktiles; }
};
struct SchedOne {
  Unit u0; const char* A; const char* B; int ktiles;
  __device__ __forceinline__ int kt(const Unit&) const { return ktiles; }
  __device__ __forceinline__ bool next(int i, Unit& u) const { if (i) return false; u = u0; return true; }
  __device__ __forceinline__ const char* aptr(const Unit&) const { return A; }
  __device__ __forceinline__ const char* bptr(const Unit&) const { return B; }
};

template <class Epi, class Sched>
__device__ __forceinline__ void gemm_phase(PG8_LAS unsigned char* lds, const int lda, const int ldb, const Sched& S, const Epi& E) {
  const int tid = tid_l(), wid = __builtin_amdgcn_readfirstlane(tid >> 6), lane = tid & 63, wr = wid >> 2, wc = wid & 3, fr = lane & 15, fq = lane >> 4;
  unsigned voffA[2], voffB[2];
#pragma unroll
  for (int i = 0; i < 2; ++i) { int R, C; stage_rc(tid * 16 + i * 8192, R, C); voffA[i] = (unsigned)(R * lda + C) * 2u; voffB[i] = (unsigned)(R * ldb + C) * 2u; }
  const size_t kstep = (size_t)(G_BK * 2);
  const size_t hstepA = (size_t)G_HALF * lda * 2, hstepB = (size_t)G_HALF * ldb * 2;
  const unsigned ldsw = (unsigned)wid * 1024u;
  const int aoff = lds_byte(wr * 64 + fr, fq * 8), boff = lds_byte(wc * 32 + fr, fq * 8);
#define PG8_SA(b, h) (((b) * 2 + (h)) * G_HTB)
#define PG8_SB(b, h) ((4 + (b) * 2 + (h)) * G_HTB)
#define PG8_STAGE(bufoff, gbase, voff) do { _Pragma("unroll") for (int _i = 0; _i < 2; ++_i) \
    __builtin_amdgcn_global_load_lds((const unsigned*)((const char*)(gbase) + (voff)[_i]), (PG8_LAS unsigned*)(lds + (bufoff) + ldsw + _i * 8192), 16, 0, 0); } while (0)
#define PG8_LDA(dst, b, h) do { _Pragma("unroll") for (int m = 0; m < 4; ++m) _Pragma("unroll") for (int k = 0; k < 2; ++k) dst[m][k] = *(const PG8_LAS bf16x8*)(lds + PG8_SA(b, h) + aoff + m * 2048 + k * 1024); } while (0)
#define PG8_LDB(dst, b, h) do { _Pragma("unroll") for (int n = 0; n < 2; ++n) _Pragma("unroll") for (int k = 0; k < 2; ++k) dst[n][k] = *(const PG8_LAS bf16x8*)(lds + PG8_SB(b, h) + boff + n * 2048 + k * 1024); } while (0)
#define PG8_MMA(ai, bj, At, Bt) do { __builtin_amdgcn_s_setprio(1); _Pragma("unroll") for (int m = 0; m < 4; ++m) _Pragma("unroll") for (int n = 0; n < 2; ++n) _Pragma("unroll") for (int k = 0; k < 2; ++k) \
    acc[ai][bj][m][n] = __builtin_amdgcn_mfma_f32_16x16x32_bf16(Bt[n][k], At[m][k], acc[ai][bj][m][n], 0, 0, 0); __builtin_amdgcn_s_setprio(0); } while (0)
#define PG8_WAIT_V(n) asm volatile("s_waitcnt vmcnt(" #n ")" ::: "memory")
#define PG8_WAIT_L(n) asm volatile("s_waitcnt lgkmcnt(" #n ")" ::: "memory")
#define PG8_BAR __builtin_amdgcn_s_barrier()
#define PG8_SCHED __builtin_amdgcn_sched_barrier(0)
  Unit cur, nxt; int ui = 0;
  if (!S.next(0, cur)) return;
  int nt = S.kt(cur);
  f32x4 acc[2][2][4][2];
#pragma unroll
  for (int a = 0; a < 2; ++a)
#pragma unroll
    for (int b = 0; b < 2; ++b)
#pragma unroll
      for (int m = 0; m < 4; ++m)
#pragma unroll
        for (int n = 0; n < 2; ++n) acc[a][b][m][n] = (f32x4){0.f, 0.f, 0.f, 0.f};
  bf16x8 At[4][2], B0[2][2], B1[2][2];
  const char* cA = S.aptr(cur); const char* cB = S.bptr(cur);
  PG8_STAGE(PG8_SB(0, 0), cB, voffB); PG8_STAGE(PG8_SA(0, 0), cA, voffA); PG8_STAGE(PG8_SB(0, 1), cB + hstepB, voffB); PG8_STAGE(PG8_SA(0, 1), cA + hstepA, voffA);
  if (wr == 1) PG8_BAR;
  PG8_WAIT_V(4); PG8_BAR;
  PG8_STAGE(PG8_SB(1, 0), cB + kstep, voffB); PG8_STAGE(PG8_SA(1, 0), cA + kstep, voffA); PG8_STAGE(PG8_SB(1, 1), cB + hstepB + kstep, voffB);
  PG8_WAIT_V(6); PG8_BAR;
  for (;;) {
    const bool has_next = S.next(ui + 1, nxt);
    const char* nA = has_next ? S.aptr(nxt) : cA; const char* nB = has_next ? S.bptr(nxt) : cB;
#pragma unroll 1
    for (int t = 0; t < nt; t += 2) {
      const bool last = (t == nt - 2);
      const char* a1 = cA + (size_t)(t + 1) * kstep;
      const char* a2 = last ? nA : cA + (size_t)(t + 2) * kstep; const char* b2 = last ? nB : cB + (size_t)(t + 2) * kstep;
      const char* a3 = a2 + kstep; const char* b3 = b2 + kstep;
      PG8_LDB(B0, 0, 0); PG8_SCHED; PG8_LDA(At, 0, 0); PG8_STAGE(PG8_SA(1, 1), a1 + hstepA, voffA);
      PG8_WAIT_L(8); PG8_BAR; PG8_WAIT_L(0); PG8_MMA(0, 0, At, B0); PG8_BAR; PG8_SCHED;
      PG8_LDB(B1, 0, 1); PG8_STAGE(PG8_SB(0, 0), b2, voffB);
      PG8_BAR; PG8_WAIT_L(0); PG8_MMA(0, 1, At, B1); PG8_BAR;
      PG8_LDA(At, 0, 1); PG8_STAGE(PG8_SA(0, 0), a2, voffA);
      PG8_BAR; PG8_WAIT_L(0); PG8_MMA(1, 0, At, B0); PG8_BAR; PG8_SCHED;
      PG8_STAGE(PG8_SB(0, 1), b2 + hstepB, voffB);
      PG8_WAIT_V(6); PG8_BAR; PG8_MMA(1, 1, At, B1); PG8_BAR;
      PG8_LDB(B0, 1, 0); PG8_SCHED; PG8_LDA(At, 1, 0); PG8_STAGE(PG8_SA(0, 1), a2 + hstepA, voffA);
      PG8_WAIT_L(8); PG8_BAR; PG8_WAIT_L(0); PG8_MMA(0, 0, At, B0); PG8_BAR; PG8_SCHED;
      PG8_LDB(B1, 1, 1); PG8_STAGE(PG8_SB(1, 0), b3, voffB);
      PG8_BAR; PG8_WAIT_L(0); PG8_MMA(0, 1, At, B1); PG8_BAR;
      PG8_LDA(At, 1, 1); PG8_STAGE(PG8_SA(1, 0), a3, voffA);
      PG8_BAR; PG8_WAIT_L(0); PG8_MMA(1, 0, At, B0); PG8_BAR; PG8_SCHED;
      PG8_STAGE(PG8_SB(1, 1), b3 + hstepB, voffB);
      PG8_WAIT_V(6); PG8_BAR; PG8_MMA(1, 1, At, B1); PG8_BAR;
    }
    E(acc, cur, wr, wc, fr, fq);
    if (!has_next) break;
#pragma unroll
    for (int a = 0; a < 2; ++a)
#pragma unroll
      for (int b = 0; b < 2; ++b)
#pragma unroll
        for (int m = 0; m < 4; ++m)
#pragma unroll
          for (int n = 0; n < 2; ++n) acc[a][b][m][n] = (f32x4){0.f, 0.f, 0.f, 0.f};
    cur = nxt; cA = nA; cB = nB; ++ui;
    nt = S.kt(cur);
  }
  PG8_WAIT_V(0);
  if (wr == 0) PG8_BAR;
  PG8_BAR;
#undef PG8_SA
#undef PG8_SB
#undef PG8_STAGE
#undef PG8_LDA
#undef PG8_LDB
#undef PG8_MMA
#undef PG8_WAIT_V
#undef PG8_WAIT_L
#undef PG8_BAR
#undef PG8_SCHED
}

struct EpiProj {
  u16* PB; u16* FT; u16* FTC; float* AB;
  __device__ __forceinline__ void operator()(const f32x4 (&acc)[2][2][4][2], const Unit& u, int wr, int wc, int fr, int fq) const {
#pragma unroll
    for (int ai = 0; ai < 2; ++ai)
#pragma unroll
      for (int m = 0; m < 4; ++m) {
        const int r = u.pm * 256 + ai * 128 + wr * 64 + m * 16 + fr;
#pragma unroll
        for (int bj = 0; bj < 2; ++bj)
#pragma unroll
          for (int n = 0; n < 2; ++n) {
            const f32x4 v = acc[ai][bj][m][n];
            const int c = u.pn * 256 + bj * 128 + wc * 32 + n * 16 + 4 * fq;
            if (u.pn < 7) {
              uint2 w; w.x = pack2(v[0], v[1]); w.y = pack2(v[2], v[3]);
              *reinterpret_cast<uint2*>(PB + (size_t)r * PBW + c) = w;
            } else {
              const int nn = c - 1792, part = nn >> 8, ch = nn & 255;
              if (u.pn == 7 && bj == 0 && wc == 1 && n == 1) {
                *reinterpret_cast<float4*>(AB + (size_t)r * 16 + 4 * fq) = make_float4(v[0], v[1], v[2], v[3]);
              } else {
                u16* d; int cstride;
                if (r < ML) { const int b = r >> 11, tt = r & 2047; d = FT + ((size_t)(b * 256)) * 4096 + part * 2048 + tt; cstride = 4096; }
                else { const int rc = r - ML, b = rc >> 8, tt = rc & 255; d = FTC + ((size_t)(b * 256)) * 512 + part * 256 + tt; cstride = 512; }
#pragma unroll
                for (int e = 0; e < 4; ++e) d[(size_t)(ch + e) * cstride] = f2bf(v[e]);
                if (u.pn == 7 && bj == 0 && wc == 0) {
#pragma unroll
                  for (int e = 0; e < 4; ++e) {
                    const int kc = n * 16 + 4 * fq + e;
                    if (kc >= 1 && kc <= 16) d[(size_t)(64 - kc) * cstride] = f2bf(v[e]);
                  }
                }
              }
            }
          }
      }
  }
};
struct EpiRes {
  const float* xin_l; const float* xin_c; float* xout_l; float* xout_c; const float* mod; int gate_off;
  __device__ __forceinline__ void operator()(const f32x4 (&acc)[2][2][4][2], const Unit& u, int wr, int wc, int fr, int fq) const {
    const int mr = (u.pm * 256 < ML) ? ((u.pm * 256) >> 11) : 32;
    const float* gp = mod + (size_t)mr * 6144 + gate_off;
#pragma unroll
    for (int ai = 0; ai < 2; ++ai)
#pragma unroll
      for (int m = 0; m < 4; ++m) {
        const int r = u.pm * 256 + ai * 128 + wr * 64 + m * 16 + fr;
        const float* xi = (r < ML) ? xin_l + (size_t)r * 1024 : xin_c + (size_t)(r - ML) * 1024;
        float* xo = (r < ML) ? xout_l + (size_t)r * 1024 : xout_c + (size_t)(r - ML) * 1024;
#pragma unroll
        for (int bj = 0; bj < 2; ++bj)
#pragma unroll
          for (int n = 0; n < 2; ++n) {
            const int c = u.pn * 256 + bj * 128 + wc * 32 + n * 16 + 4 * fq;
            const float4 g = *reinterpret_cast<const float4*>(gp + c);
            const float4 x = *reinterpret_cast<const float4*>(xi + c);
            const f32x4 v = acc[ai][bj][m][n];
            *reinterpret_cast<float4*>(xo + c) = make_float4(x.x + g.x * v[0], x.y + g.y * v[1], x.z + g.z * v[2], x.w + g.w * v[3]);
          }
      }
  }
};
struct EpiFfn1 {
  u16* HID;
  __device__ __forceinline__ void operator()(const f32x4 (&acc)[2][2][4][2], const Unit& u, int wr, int wc, int fr, int fq) const {
#pragma unroll
    for (int ai = 0; ai < 2; ++ai)
#pragma unroll
      for (int m = 0; m < 4; ++m) {
        const int r = u.pm * 256 + ai * 128 + wr * 64 + m * 16 + fr;
#pragma unroll
        for (int n = 0; n < 2; ++n) {
          const f32x4 g = acc[ai][0][m][n], up = acc[ai][1][m][n];
          const int c = u.pn * 128 + wc * 32 + n * 16 + 4 * fq;
          uint2 w;
          w.x = pack2(silu_f(g[0]) * up[0], silu_f(g[1]) * up[1]);
          w.y = pack2(silu_f(g[2]) * up[2], silu_f(g[3]) * up[3]);
          *reinterpret_cast<uint2*>(HID + (size_t)r * DFF + c) = w;
        }
      }
  }
};
struct EpiFnet {
  u16* Y; int rowbase; int rows_per_b;
  __device__ __forceinline__ void operator()(const f32x4 (&acc)[2][2][4][2], const Unit& u, int wr, int wc, int fr, int fq) const {
#pragma unroll
    for (int ai = 0; ai < 2; ++ai)
#pragma unroll
      for (int m = 0; m < 4; ++m) {
        const size_t r = (size_t)rowbase + (size_t)u.pn * rows_per_b + u.pm * 256 + ai * 128 + wr * 64 + m * 16 + fr;
#pragma unroll
        for (int bj = 0; bj < 2; ++bj)
#pragma unroll
          for (int n = 0; n < 2; ++n) {
            const f32x4 v = acc[ai][bj][m][n];
            const int c = 256 + bj * 128 + wc * 32 + n * 16 + 4 * fq;
            uint2 w; w.x = pack2(v[0], v[1]); w.y = pack2(v[2], v[3]);
            *reinterpret_cast<uint2*>(Y + r * 1024 + c) = w;
          }
      }
  }
};

__device__ __forceinline__ int srccol(int mat, int n) {
  if (mat == 0) {
    if (n < 768) return n;
    if (n < 1024) return 784 + (n - 768);
    if (n < 1280) return 1040 + (n - 1024);
    if (n < 1536) return 1552 + (n - 1280);
    if (n < 1792) return 1808 + (n - 1536);
    return -1;
  }
  if (mat == 1 || mat == 2) {
    const int un = n >> 8, pos = n & 255;
    const int bj = pos >> 7, wc = (pos >> 5) & 3, nn = (pos >> 4) & 1, f = pos & 15;
    if (mat == 1) {
      const int dq = un >> 2, q = un & 3;
      return 2064 + (2 * bj + nn) * 1024 + dq * 256 + 64 * q + 16 * wc + f;
    }
    return un * 256 + 64 * (2 * bj + nn) + 16 * wc + f;
  }
  if (mat == 4) {
    const int pn = n >> 8, bj = (n >> 7) & 1, jj = n & 127;
    return bj * DFF + pn * 128 + jj;
  }
  return n;
}

__device__ __forceinline__ void transpose_tile(const float* __restrict__ src, int ld, int mat, u16* __restrict__ dst, int Kd, int n0, int k0, float* lds) {
  const int tid = tid_l();
  const int nn = tid & 63, kq = tid >> 6;
  const int sc = srccol(mat, n0 + nn);
  float v[32];
#pragma unroll
  for (int i = 0; i < 32; ++i) v[i] = (sc >= 0) ? src[(size_t)(k0 + kq + i * 8) * ld + sc] : 0.f;
#pragma unroll
  for (int i = 0; i < 32; ++i) { const int kk = kq + i * 8; lds[(kk >> 6) * 4160 + (kk & 63) * 65 + nn] = v[i]; }
  __syncthreads();
#pragma unroll
  for (int it = 0; it < 4; ++it) {
    const int e = tid + it * NT, sub = e >> 9, e2 = e & 511, n2 = e2 >> 3, k8 = e2 & 7;
    const float* L = lds + sub * 4160;
    uint4 w;
    w.x = pack2(L[(k8 * 8 + 0) * 65 + n2], L[(k8 * 8 + 1) * 65 + n2]);
    w.y = pack2(L[(k8 * 8 + 2) * 65 + n2], L[(k8 * 8 + 3) * 65 + n2]);
    w.z = pack2(L[(k8 * 8 + 4) * 65 + n2], L[(k8 * 8 + 5) * 65 + n2]);
    w.w = pack2(L[(k8 * 8 + 6) * 65 + n2], L[(k8 * 8 + 7) * 65 + n2]);
    *reinterpret_cast<uint4*>(dst + (size_t)(n0 + n2) * Kd + k0 + sub * 64 + k8 * 8) = w;
  }
  __syncthreads();
}

constexpr int P0_MOD = 192;
constexpr int P0_TPL = 1060;
constexpr int P0_TR = P0_TPL * 4;
constexpr int P0_FF = 256, P0_WF = 256, P0_DFT = 260, P0_SGW = 64;
constexpr int P0_TOTAL = P0_MOD + P0_TR + P0_FF + P0_WF + P0_DFT + P0_SGW;

__device__ __forceinline__ void phase0(const Params& p, char* smem) {
  const int tid = tid_l();
  u16* Wall = reinterpret_cast<u16*>(p.ws + OFF_W);
  float* lds = reinterpret_cast<float*>(smem);
  for (int it = blockIdx.x; it < P0_TOTAL; it += gridDim.x) {
    if (it < P0_MOD) {
      const int kq = it & 3, it4 = it >> 2;
      const int l = it4 / 12, n = (it4 % 12) * 512 + tid;
      const float* aw = p.in[4] + (size_t)l * 1024 * 6144;
      float acc[36];
#pragma unroll
      for (int r = 0; r < 36; ++r) acc[r] = 0.f;
      for (int k0 = kq * 256; k0 < kq * 256 + 256; k0 += 64) {
        __syncthreads();
        for (int e = tid; e < 64 * 36; e += NT) {
          const int kk = e / 36, r = e - kk * 36;
          float v = 0.f;
          if (r < 32) v = silu_f(p.in[1][r * 1024 + k0 + kk]);
          else if (r == 32) v = silu_f(p.in[3][k0 + kk]);
          lds[e] = v;
        }
        __syncthreads();
#pragma unroll 4
        for (int kk = 0; kk < 64; ++kk) {
          const float w = aw[(size_t)(k0 + kk) * 6144 + n];
          const float4* sp = reinterpret_cast<const float4*>(lds + kk * 36);
#pragma unroll
          for (int r4 = 0; r4 < 9; ++r4) {
            const float4 s = sp[r4];
            acc[r4 * 4 + 0] += s.x * w; acc[r4 * 4 + 1] += s.y * w; acc[r4 * 4 + 2] += s.z * w; acc[r4 * 4 + 3] += s.w * w;
          }
        }
      }
      float* modp = reinterpret_cast<float*>(p.ws + OFF_PB) + ((size_t)kq * 4 + l) * 33 * 6144;
#pragma unroll
      for (int r = 0; r < 33; ++r) modp[(size_t)r * 6144 + n] = acc[r];
      __syncthreads();
      continue;
    }
    int q = it - P0_MOD;
    {
      const int NMID = P0_FF + P0_WF + P0_DFT;
      if (q < NMID) q += P0_TR;
      else if (q < NMID + P0_TR) q -= NMID;
    }
    if (q < P0_TR) {
      const int l = q / P0_TPL;
      int r = q - l * P0_TPL;
      u16* Wl = Wall + (size_t)l * LAYER_W;
      if (r < 144) {
        const int ntile = r >> 2, kt = r & 3;
        if (ntile >= 28 && ntile < 36) continue;
        transpose_tile(p.in[8] + (size_t)l * 1024 * DIN, DIN, 0, Wl + WIN_OFF, 1024, ntile * 64, kt * 256, lds);
        continue;
      }
      r -= 144;
      if (r < 256) {
        transpose_tile(p.in[8] + (size_t)l * 1024 * DIN, DIN, 1, Wl + WG_OFF, 1024, (r >> 2) * 64, (r & 3) * 256, lds);
        continue;
      }
      r -= 256;
      if (r < 64) {
        const int kt = r & 3;
        if (kt == 1) continue;
        transpose_tile(p.in[28] + (size_t)l * 1024 * 1024, 1024, 2, Wl + WB_OFF, 1024, (r >> 2) * 64, kt * 256, lds);
        continue;
      }
      r -= 64;
      if (r < 64) {
        transpose_tile(p.in[29] + (size_t)l * 1024 * 1024, 1024, 3, Wl + WO_OFF, 1024, (r >> 2) * 64, (r & 3) * 256, lds);
        continue;
      }
      r -= 64;
      if (r < 352) {
        transpose_tile(p.in[30] + (size_t)l * 1024 * 5632, 5632, 4, Wl + W1_OFF, 1024, (r >> 2) * 64, (r & 3) * 256, lds);
        continue;
      }
      r -= 352;
      if (r < 176) {
        const int ntile = r / 11, kt = r - ntile * 11;
        transpose_tile(p.in[31] + (size_t)l * DFF * 1024, 1024, 5, Wl + W2_OFF, DFF, ntile * 64, kt * 256, lds);
        continue;
      }
      r -= 176;
      {
        transpose_tile(p.in[17] + (size_t)l * 65536, 256, 6, Wl + GLU_OFF, 256, r * 64, 0, lds);
        continue;
      }
    }
    q -= P0_TR;
    if (q < P0_FF) {
      const int l = q >> 6, g = (q >> 4) & 3, kt = q & 15, k0 = kt * 64;
      const float* src = p.in[8] + (size_t)l * 1024 * DIN;
      float* wt = lds;
      float* ct = lds + 64 * 65;
      float* st = ct + 64;
      __syncthreads();
      for (int e = tid; e < 4096; e += NT) {
        const int kk = e >> 6, c = e & 63;
        wt[kk * 65 + c] = src[(size_t)(k0 + kk) * DIN + 1296 + g * 64 + c];
      }
      if (tid < 64) {
        float s, c;
        sincospif((float)tid / 32.f, &s, &c);
        ct[tid] = c; st[tid] = s;
      }
      __syncthreads();
      u16* WinT = Wall + (size_t)l * LAYER_W + WIN_OFF;
      for (int e = tid; e < 4096; e += NT) {
        const int j = e >> 6, kk = e & 63;
        float sc = 0.f, ss = 0.f;
        for (int c = 0; c < 64; ++c) {
          const float w = wt[kk * 65 + c];
          const int m = (c * j) & 63;
          sc += w * ct[m];
          ss += w * st[m];
        }
        if (g == 0 && j >= 48) sc = src[(size_t)(k0 + kk) * DIN + 768 + (j - 48)];
        WinT[(size_t)(1792 + g * 64 + j) * 1024 + k0 + kk] = f2bf(sc);
        WinT[(size_t)(2048 + g * 64 + j) * 1024 + k0 + kk] = f2bf(ss);
      }
      __syncthreads();
      continue;
    }
    q -= P0_FF;
    if (q < P0_WF) {
      const int l = q >> 6, g = (q >> 4) & 3, dt = q & 15, d0 = dt * 64;
      float* wb = lds;
      float* fw = lds + 64 * 65;
      __syncthreads();
      for (int e2 = tid; e2 < 4096; e2 += NT) {
        const int e = e2 >> 6, dd = e2 & 63;
        wb[e * 65 + dd] = p.in[28][((size_t)(l * 4 + 1) * 256 + g * 64 + e) * 1024 + d0 + dd];
        fw[e * 65 + dd] = p.in[19][((size_t)(l * 4 + g) * 64 + e) * 64 + dd];
      }
      __syncthreads();
      u16* WbT = Wall + (size_t)l * LAYER_W + WB_OFF;
      for (int e2 = tid; e2 < 4096; e2 += NT) {
        const int c = e2 & 63, dd = e2 >> 6;
        float v = 0.f;
        for (int e = 0; e < 64; ++e) v += fw[c * 65 + e] * wb[e * 65 + dd];
        const int dfull = d0 + dd, dl = dfull & 255, qq = dl >> 6, xx = dl & 63;
        const int prow = (dfull & ~255) + 128 * (qq >> 1) + 32 * (xx >> 4) + 16 * (qq & 1) + (xx & 15);
        WbT[(size_t)prow * 1024 + 256 + g * 64 + c] = f2bf(v);
      }
      __syncthreads();
      continue;
    }
    q -= P0_WF;
    if (q < P0_DFT) {
      if (q < 256) {
        u16* DL = reinterpret_cast<u16*>(p.ws + OFF_DL);
        const float scale = 0.0027621358640099515f;
        for (int e = tid; e < 4096; e += NT) {
          const int k = q * 8 + (e >> 9), c8 = e & 511, col0 = c8 * 8;
          const int part = col0 >= 2048, l0 = col0 & 2047;
          unsigned w[4];
#pragma unroll
          for (int jj = 0; jj < 8; jj += 2) {
            float s0, c0, s1, c1;
            sincospif((float)((k * (l0 + jj)) & 2047) / 1024.f, &s0, &c0);
            sincospif((float)((k * (l0 + jj + 1)) & 2047) / 1024.f, &s1, &c1);
            const float v0 = (part ? -s0 : c0) * scale, v1 = (part ? -s1 : c1) * scale;
            w[jj >> 1] = pack2(v0, v1);
          }
          *reinterpret_cast<uint4*>(DL + (size_t)k * 4096 + col0) = make_uint4(w[0], w[1], w[2], w[3]);
        }
      } else {
        u16* DC = reinterpret_cast<u16*>(p.ws + OFF_DC);
        const float scale = 1.f / 128.f;
        const int qq = q - 256;
        for (int e = tid; e < 4096; e += NT) {
          const int k = qq * 64 + (e >> 6), c8 = e & 63, col0 = c8 * 8;
          const int part = col0 >= 256, l0 = col0 & 255;
          unsigned w[4];
#pragma unroll
          for (int jj = 0; jj < 8; jj += 2) {
            float s0, c0, s1, c1;
            sincospif((float)((k * (l0 + jj)) & 255) / 128.f, &s0, &c0);
            sincospif((float)((k * (l0 + jj + 1)) & 255) / 128.f, &s1, &c1);
            const float v0 = (part ? -s0 : c0) * scale, v1 = (part ? -s1 : c1) * scale;
            w[jj >> 1] = pack2(v0, v1);
          }
          *reinterpret_cast<uint4*>(DC + (size_t)k * 512 + col0) = make_uint4(w[0], w[1], w[2], w[3]);
        }
      }
      continue;
    }
    q -= P0_DFT;
    {
      u16* SGW = reinterpret_cast<u16*>(p.ws + OFF_SGW);
      for (int e = tid; e < 4096; e += NT) {
        const int idx = q * 4096 + e;
        SGW[idx] = f2bf(p.in[26][idx]);
      }
    }
  }
}

__device__ __forceinline__ void mod_combine(const Params& p) {
  const float* modp = reinterpret_cast<const float*>(p.ws + OFF_PB);
  float* mod = reinterpret_cast<float*>(p.ws + OFF_MOD);
  const int total = 4 * 33 * 6144, Q = 4 * 33 * 6144;
  for (int i = blockIdx.x * NT + tid_l(); i < total; i += gridDim.x * NT) {
    const int l = i / (33 * 6144), n = i % 6144;
    mod[i] = ((modp[i] + modp[Q + i]) + (modp[2 * Q + i] + modp[3 * Q + i])) + p.in[5][l * 6144 + n];
  }
}

__device__ __forceinline__ int mod_row(int r) { return r < ML ? (r >> 11) : 32; }

__device__ __forceinline__ void phase_norm(const Params& p, int l, int which, int Mrows) {
  const int tid = tid_l();
  const int lane = tid & 63;
  const int gw = blockIdx.x * NW + (tid >> 6), tw = gridDim.x * NW;
  const float* nw = p.in[which ? 7 : 6] + l * 1024;
  const float* mod = reinterpret_cast<const float*>(p.ws + OFF_MOD) + (size_t)l * 33 * 6144;
  const int sh_off = which ? 3072 : 0, sc_off = which ? 4096 : 1024;
  u16* H = reinterpret_cast<u16*>(p.ws + OFF_H);
  const bool first = (l == 0 && which == 0);
  for (int r0 = gw * 4; r0 < Mrows; r0 += tw * 4) {
    const float* xr;
    if (r0 < ML) xr = (first ? p.in[0] : p.out) + (size_t)r0 * 1024;
    else xr = (first ? p.in[2] : reinterpret_cast<const float*>(p.ws + OFF_XC)) + (size_t)(r0 - ML) * 1024;
    float4 v[4][4];
#pragma unroll
    for (int j = 0; j < 4; ++j)
#pragma unroll
      for (int i = 0; i < 4; ++i) v[j][i] = *reinterpret_cast<const float4*>(xr + j * 1024 + i * 256 + lane * 4);
    float rs[4];
#pragma unroll
    for (int j = 0; j < 4; ++j) {
      float ss = 0.f;
#pragma unroll
      for (int i = 0; i < 4; ++i) ss += v[j][i].x * v[j][i].x + v[j][i].y * v[j][i].y + v[j][i].z * v[j][i].z + v[j][i].w * v[j][i].w;
      ss = reduce8(ss);
      ss += dpp_f<0x140>(ss);
      ss += __shfl_xor(ss, 16);
      ss += __shfl_xor(ss, 32);
      rs[j] = rsqrtf(ss * (1.f / 1024.f) + EPS);
    }
    const float* mr = mod + (size_t)mod_row(r0) * 6144;
#pragma unroll
    for (int i = 0; i < 4; ++i) {
      const int c = i * 256 + lane * 4;
      const float4 g = *reinterpret_cast<const float4*>(nw + c);
      const float4 sc = *reinterpret_cast<const float4*>(mr + sc_off + c);
      const float4 sh = *reinterpret_cast<const float4*>(mr + sh_off + c);
      const float m0 = g.x * (1.f + sc.x), m1 = g.y * (1.f + sc.y), m2 = g.z * (1.f + sc.z), m3 = g.w * (1.f + sc.w);
#pragma unroll
      for (int j = 0; j < 4; ++j) {
        uint2 w;
        w.x = pack2(v[j][i].x * rs[j] * m0 + sh.x, v[j][i].y * rs[j] * m1 + sh.y);
        w.y = pack2(v[j][i].z * rs[j] * m2 + sh.z, v[j][i].w * rs[j] * m3 + sh.w);
        *reinterpret_cast<uint2*>(H + (size_t)(r0 + j) * 1024 + c) = w;
      }
    }
  }
}

__device__ __forceinline__ void phase_proj(const Params& p, int l, char* smem) {
  const u16* H = reinterpret_cast<const u16*>(p.ws + OFF_H);
  const u16* WinT = reinterpret_cast<const u16*>(p.ws + OFF_W) + (size_t)l * LAYER_W + WIN_OFF;
  EpiProj E;
  E.PB = reinterpret_cast<u16*>(p.ws + OFF_PB);
  E.FT = reinterpret_cast<u16*>(p.ws + OFF_FT);
  E.FTC = reinterpret_cast<u16*>(p.ws + OFF_FTC);
  E.AB = reinterpret_cast<float*>(p.ws + OFF_AB);
  if (l < DEPTH - 1) {
    SchedStd S;
    S.init(MT / 256, NPROJ / 256, 1024, H, (size_t)256 * 1024 * 2, WinT, (size_t)256 * 1024 * 2);
    gemm_phase((PG8_LAS unsigned char*)(smem), 1024, 1024, S, E);
  } else {
    SchedProjLast S;
    S.s.init(ML / 256, NPROJ / 256, 1024, H, (size_t)256 * 1024 * 2, WinT, (size_t)256 * 1024 * 2);
    gemm_phase((PG8_LAS unsigned char*)(smem), 1024, 1024, S, E);
  }
}

typedef float f32x2 __attribute__((ext_vector_type(2)));
__device__ __forceinline__ void gdn_block(const Params& p, int l, int b, int h, int dir, char* smem, bool ctx_out) {
  const int tid = tid_l(), lane = tid & 63, wid = tid >> 6;
  float* Lbase = reinterpret_cast<float*>(smem);
  constexpr int BUFSZ = 3 * 32 * 68 + 128 + 32 + 64 * 36;
  float* Lo_base = Lbase + 2 * BUFSZ;
  const u16* PB = reinterpret_cast<const u16*>(p.ws + OFF_PB);
  const float* AB = reinterpret_cast<const float*>(p.ws + OFF_AB);
  u16* O = reinterpret_cast<u16*>(p.ws + (dir ? OFF_OGB : OFF_OGF));
  const float Acoef = -__expf(p.in[21][l * 8 + dir * 4 + h]);
  const float dtb = p.in[22][l * 8 + dir * 4 + h];
  const int pj = tid >> 4, oc = tid & 15;
  float wreg[3][12];
  {
    const float* cw = p.in[20] + (size_t)l * 3 * 256 * 3;
#pragma unroll
    for (int x = 0; x < 3; ++x) {
      const float4* wp = reinterpret_cast<const float4*>(cw + (size_t)(x * 256 + h * 64 + oc * 4) * 3);
#pragma unroll
      for (int i = 0; i < 3; ++i) { const float4 t = wp[i]; wreg[x][i * 4] = t.x; wreg[x][i * 4 + 1] = t.y; wreg[x][i * 4 + 2] = t.z; wreg[x][i * 4 + 3] = t.w; }
    }
  }
  f32x4 Sacc[4];
#pragma unroll
  for (int i = 0; i < 4; ++i) Sacc[i] = f32x4{0.f, 0.f, 0.f, 0.f};
  uint2 rg[3][3];
  float ral = 0.f, rbl = 0.f;
  constexpr int NCH = (CTXL + SEQ) / 32;
  auto issue_loads = [&](int cc) {
    const int seg = cc >= CTXL / 32, c0 = seg ? cc - CTXL / 32 : cc;
    const int Ls = seg ? SEQ : CTXL, rowbase = seg ? b * SEQ : ML + b * CTXL;
    const int tpos = dir ? (Ls - 1 - (c0 * 32 + pj)) : (c0 * 32 + pj);
    const size_t row = (size_t)(rowbase + tpos);
    const bool vm = tpos > 0, vp = tpos < Ls - 1;
#pragma unroll
    for (int x = 0; x < 3; ++x) {
      const u16* s0 = PB + row * PBW + (x == 0 ? PB_K : (x == 1 ? PB_V : PB_Q)) + h * 64 + oc * 4;
      rg[x][1] = *reinterpret_cast<const uint2*>(s0);
      rg[x][0] = make_uint2(0, 0); rg[x][2] = make_uint2(0, 0);
      if (vm) rg[x][0] = *reinterpret_cast<const uint2*>(s0 - PBW);
      if (vp) rg[x][2] = *reinterpret_cast<const uint2*>(s0 + PBW);
    }
    if (oc == 0) { ral = AB[row * 16 + dir * 4 + h]; rbl = AB[row * 16 + 8 + dir * 4 + h]; }
  };
  auto write_out = [&](int cc) {
    const int seg = cc >= CTXL / 32, c0 = seg ? cc - CTXL / 32 : cc;
    if (!(seg || ctx_out)) return;
    const int Ls = seg ? SEQ : CTXL, rowbase = seg ? b * SEQ : ML + b * CTXL;
    const int tpos = dir ? (Ls - 1 - (c0 * 32 + pj)) : (c0 * 32 + pj);
    const float4 o4 = *reinterpret_cast<const float4*>(Lo_base + (cc & 1) * 2048 + pj * 64 + oc * 4);
    uint2 w; w.x = pack2(o4.x, o4.y); w.y = pack2(o4.z, o4.w);
    *reinterpret_cast<uint2*>(O + (size_t)(rowbase + tpos) * 256 + h * 64 + oc * 4) = w;
  };
  __syncthreads();
  issue_loads(0);
#pragma unroll 1
  for (int cc = 0; cc < NCH; ++cc) {
    float* Lk = Lbase + (cc & 1) * BUFSZ;
    float* Lq = Lk + 32 * 68;
    float* Lv = Lq + 32 * 68;
    float4* Lc = reinterpret_cast<float4*>(Lv + 32 * 68);
    float yk[4] = {0.f, 0.f, 0.f, 0.f};
    float qkd = 0.f;
#pragma unroll
    for (int x = 0; x < 3; ++x) {
      float y[4];
      float ss = 0.f;
#pragma unroll
      for (int e = 0; e < 4; ++e) {
        const unsigned wm = (e < 2) ? rg[x][0].x : rg[x][0].y, w0 = (e < 2) ? rg[x][1].x : rg[x][1].y, wpp = (e < 2) ? rg[x][2].x : rg[x][2].y;
        const float xm = (e & 1) ? hi2f(wm) : lo2f(wm), x0 = (e & 1) ? hi2f(w0) : lo2f(w0), xp = (e & 1) ? hi2f(wpp) : lo2f(wpp);
        float v = wreg[x][e * 3 + 0] * xm + wreg[x][e * 3 + 1] * x0 + wreg[x][e * 3 + 2] * xp;
        v = silu_f(v);
        y[e] = v;
        ss += v * v;
      }
      if (x != 1) {
        ss = reduce16(ss);
        float sc = rsqrtf(ss + EPS);
        if (x == 2) sc *= 0.125f;
#pragma unroll
        for (int e = 0; e < 4; ++e) y[e] *= sc;
      }
      if (x == 0) {
        float* LkT = Lk + 3 * 32 * 68 + 160;
#pragma unroll
        for (int e = 0; e < 4; ++e) { yk[e] = y[e]; LkT[(oc * 4 + e) * 36 + pj] = y[e]; }
      }
      if (x == 2) {
        float d = y[0] * yk[0] + y[1] * yk[1] + y[2] * yk[2] + y[3] * yk[3];
        d = reduce16(d);
        qkd = d;
      }
      float* dst = (x == 0 ? Lk : (x == 1 ? Lv : Lq)) + pj * 68 + oc * 4;
      *reinterpret_cast<float4*>(dst) = make_float4(y[0], y[1], y[2], y[3]);
    }
    if (oc == 0) { const float gl = Acoef * softplus_f(ral + dtb); Lc[pj] = make_float4(__expf(gl), sigm(rbl), qkd, gl); }
    __syncthreads();
    if (cc > 0) write_out(cc - 1);
    if (cc + 1 < NCH) issue_loads(cc + 1);
    if (wid < 4) {
      float* Lo = Lo_base + (cc & 1) * 2048;
      float* W = Lo_base + 4096 + wid * 1408;
      float* A1 = W; float* A2 = W + 256; float* KSs = W + 512; float* QSs = W + 768; float* DlT = W + 1024;
      float* Cs = W + 1280; float* Ecs = W + 1296; float* E15 = W + 1312; float* Bts = W + 1328;
      const float* LkT = Lk + 3 * 32 * 68 + 160;
      const int fr = lane & 15, fq = lane >> 4, vq = lane >> 2, sq = lane & 3;
      const float4* Lc4 = reinterpret_cast<const float4*>(Lv + 32 * 68);
#pragma unroll 1
      for (int mc = 0; mc < 2; ++mc) {
        const int tb = mc * 16;
        {
          float ct = 0.f, c15 = 0.f;
#pragma unroll
          for (int j = 0; j < 16; ++j) { const float gj = Lc4[tb + j].w; c15 += gj; ct += (j <= fr) ? gj : 0.f; }
          if (lane < 16) { Cs[lane] = ct; Ecs[lane] = __expf(ct); E15[lane] = __expf(c15 - ct); Bts[lane] = Lc4[tb + lane].y; }
        }
        bf16x8 kf[2], qf[2], kp[2], qp[2];
#pragma unroll
        for (int ks = 0; ks < 2; ++ks) {
          const float* kr = Lk + (tb + fr) * 68;
          const float* qr = Lq + (tb + fr) * 68;
          const float4 a0 = *reinterpret_cast<const float4*>(kr + ks * 32 + fq * 8), a1 = *reinterpret_cast<const float4*>(kr + ks * 32 + fq * 8 + 4);
          const float4 b0 = *reinterpret_cast<const float4*>(qr + ks * 32 + fq * 8), b1 = *reinterpret_cast<const float4*>(qr + ks * 32 + fq * 8 + 4);
          const float4 c0 = *reinterpret_cast<const float4*>(kr + (2 * ks) * 16 + fq * 4), c1 = *reinterpret_cast<const float4*>(kr + (2 * ks + 1) * 16 + fq * 4);
          const float4 d0 = *reinterpret_cast<const float4*>(qr + (2 * ks) * 16 + fq * 4), d1 = *reinterpret_cast<const float4*>(qr + (2 * ks + 1) * 16 + fq * 4);
          const uint4 ua = make_uint4(pack2(a0.x, a0.y), pack2(a0.z, a0.w), pack2(a1.x, a1.y), pack2(a1.z, a1.w));
          const uint4 ub = make_uint4(pack2(b0.x, b0.y), pack2(b0.z, b0.w), pack2(b1.x, b1.y), pack2(b1.z, b1.w));
          const uint4 uc = make_uint4(pack2(c0.x, c0.y), pack2(c0.z, c0.w), pack2(c1.x, c1.y), pack2(c1.z, c1.w));
          const uint4 ud = make_uint4(pack2(d0.x, d0.y), pack2(d0.z, d0.w), pack2(d1.x, d1.y), pack2(d1.z, d1.w));
          kf[ks] = __builtin_bit_cast(bf16x8, ua); qf[ks] = __builtin_bit_cast(bf16x8, ub);
          kp[ks] = __builtin_bit_cast(bf16x8, uc); qp[ks] = __builtin_bit_cast(bf16x8, ud);
        }
        f32x4 g1 = f32x4{0.f, 0.f, 0.f, 0.f}, g2 = f32x4{0.f, 0.f, 0.f, 0.f}, ks0 = f32x4{0.f, 0.f, 0.f, 0.f}, qs0 = f32x4{0.f, 0.f, 0.f, 0.f};
#pragma unroll
        for (int ks = 0; ks < 2; ++ks) {
          const uint4 us = make_uint4(pack2(Sacc[2 * ks][0], Sacc[2 * ks][1]), pack2(Sacc[2 * ks][2], Sacc[2 * ks][3]),
                                      pack2(Sacc[2 * ks + 1][0], Sacc[2 * ks + 1][1]), pack2(Sacc[2 * ks + 1][2], Sacc[2 * ks + 1][3]));
          const bf16x8 sf = __builtin_bit_cast(bf16x8, us);
          g1 = __builtin_amdgcn_mfma_f32_16x16x32_bf16(kf[ks], kf[ks], g1, 0, 0, 0);
          g2 = __builtin_amdgcn_mfma_f32_16x16x32_bf16(qf[ks], kf[ks], g2, 0, 0, 0);
          ks0 = __builtin_amdgcn_mfma_f32_16x16x32_bf16(kp[ks], sf, ks0, 0, 0, 0);
          qs0 = __builtin_amdgcn_mfma_f32_16x16x32_bf16(qp[ks], sf, qs0, 0, 0, 0);
        }
        WAVE_SYNC();
        {
          const float cs = Cs[fr];
          const float4 ct4 = *reinterpret_cast<const float4*>(Cs + fq * 4);
          const float4 bt4 = *reinterpret_cast<const float4*>(Bts + fq * 4);
          const float ctv[4] = {ct4.x, ct4.y, ct4.z, ct4.w}, btv[4] = {bt4.x, bt4.y, bt4.z, bt4.w};
#pragma unroll
          for (int i = 0; i < 4; ++i) {
            const int t = fq * 4 + i;
            const float e = __expf(fminf(ctv[i] - cs, 0.f));
            A1[t * 16 + fr] = (fr < t) ? btv[i] * g1[i] * e : 0.f;
            A2[t * 16 + fr] = (fr <= t) ? g2[i] * e : 0.f;
            KSs[t * 16 + fr] = ks0[i];
            QSs[t * 16 + fr] = qs0[i];
          }
        }
        WAVE_SYNC();
        float dreg[4] = {0.f, 0.f, 0.f, 0.f};
        float na1[4], na2[4], nbt, nec, nv, nks, nqs;
#pragma unroll
        for (int j = 0; j < 4; ++j) { na1[j] = A1[sq + 4 * j]; na2[j] = A2[sq + 4 * j]; }
        nbt = Bts[0]; nec = Ecs[0]; nv = Lv[tb * 68 + wid * 16 + vq]; nks = KSs[vq]; nqs = QSs[vq];
#pragma unroll
        for (int t = 0; t < 16; ++t) {
          float a1[4], a2[4];
#pragma unroll
          for (int j = 0; j < 4; ++j) { a1[j] = na1[j]; a2[j] = na2[j]; }
          const float bt = nbt, ec = nec, vv = nv, ksv = nks, qsv = nqs;
          if (t < 15) {
#pragma unroll
            for (int j = 0; j < (t + 4) / 4; ++j) na1[j] = A1[(t + 1) * 16 + sq + 4 * j];
#pragma unroll
            for (int j = 0; j <= ((t + 1) >> 2); ++j) na2[j] = A2[(t + 1) * 16 + sq + 4 * j];
            nbt = Bts[t + 1]; nec = Ecs[t + 1]; nv = Lv[(tb + t + 1) * 68 + wid * 16 + vq]; nks = KSs[(t + 1) * 16 + vq]; nqs = QSs[(t + 1) * 16 + vq];
          }
          float part = 0.f;
#pragma unroll
          for (int j = 0; j < (t + 3) / 4; ++j) part += a1[j] * dreg[j];
          part = reduce4(part);
          const float dt = bt * vv - bt * ec * ksv - part;
          dreg[t >> 2] = (sq == (t & 3)) ? dt : dreg[t >> 2];
          float po = 0.f;
#pragma unroll
          for (int j = 0; j <= (t >> 2); ++j) po += a2[j] * dreg[j];
          po = reduce4(po);
          Lo[(tb + t) * 64 + wid * 16 + vq] = ec * qsv + po;
          DlT[vq * 16 + t] = dt;
        }
        WAVE_SYNC();
        {
          const float Dd = Ecs[15];
          bf16x8 df = {0, 0, 0, 0, 0, 0, 0, 0};
          float4 e0 = make_float4(0.f, 0.f, 0.f, 0.f), e1 = e0;
          if (fq < 2) {
            const float4 x0 = *reinterpret_cast<const float4*>(DlT + fr * 16 + fq * 8), x1 = *reinterpret_cast<const float4*>(DlT + fr * 16 + fq * 8 + 4);
            const uint4 ux = make_uint4(pack2(x0.x, x0.y), pack2(x0.z, x0.w), pack2(x1.x, x1.y), pack2(x1.z, x1.w));
            df = __builtin_bit_cast(bf16x8, ux);
            e0 = *reinterpret_cast<const float4*>(E15 + fq * 8); e1 = *reinterpret_cast<const float4*>(E15 + fq * 8 + 4);
          }
#pragma unroll
          for (int mt = 0; mt < 4; ++mt) {
            bf16x8 kt = {0, 0, 0, 0, 0, 0, 0, 0};
            if (fq < 2) {
              const float4 x0 = *reinterpret_cast<const float4*>(LkT + (mt * 16 + fr) * 36 + tb + fq * 8), x1 = *reinterpret_cast<const float4*>(LkT + (mt * 16 + fr) * 36 + tb + fq * 8 + 4);
              const uint4 ux = make_uint4(pack2(x0.x * e0.x, x0.y * e0.y), pack2(x0.z * e0.z, x0.w * e0.w), pack2(x1.x * e1.x, x1.y * e1.y), pack2(x1.z * e1.z, x1.w * e1.w));
              kt = __builtin_bit_cast(bf16x8, ux);
            }
            f32x4 sc = Sacc[mt];
            sc[0] *= Dd; sc[1] *= Dd; sc[2] *= Dd; sc[3] *= Dd;
            Sacc[mt] = __builtin_amdgcn_mfma_f32_16x16x32_bf16(kt, df, sc, 0, 0, 0);
          }
        }
        WAVE_SYNC();
      }
    }
  }
  __syncthreads();
  write_out(NCH - 1);
}

__device__ __forceinline__ void gdn_block3(const Params& p, int l, int b, int h, int dir, char* smem, bool ctx_out) {
  const int tid = tid_l(), lane = tid & 63, wid = tid >> 6;
  float* Lbase = reinterpret_cast<float*>(smem);
  constexpr int BUFSZ = 3 * 32 * 68 + 128 + 32 + 64 * 36;
  float* Lo_base = Lbase + 2 * BUFSZ;
  float* Lw = Lo_base + 4096 + 4 * 1408;
  const u16* PB = reinterpret_cast<const u16*>(p.ws + OFF_PB);
  const float* AB = reinterpret_cast<const float*>(p.ws + OFF_AB);
  u16* O = reinterpret_cast<u16*>(p.ws + (dir ? OFF_OGB : OFF_OGF));
  const float Acoef = -__expf(p.in[21][l * 8 + dir * 4 + h]);
  const float dtb = p.in[22][l * 8 + dir * 4 + h];
  const int t2 = tid & 255, pj = t2 >> 3, oc = t2 & 7;
  __syncthreads();
  {
    const float* cw = p.in[20] + (size_t)l * 3 * 256 * 3;
    for (int e = tid; e < 576; e += NT) { const int x = e / 192, r = e - x * 192; Lw[e] = cw[(size_t)(x * 256 + h * 64) * 3 + r]; }
  }
  __syncthreads();
  f32x4 Sacc[4];
#pragma unroll
  for (int i = 0; i < 4; ++i) Sacc[i] = f32x4{0.f, 0.f, 0.f, 0.f};
  constexpr int NCH = (CTXL + SEQ) / 32;
  auto prep_chunk = [&](int cc) {
    const int seg = cc >= CTXL / 32, c0 = seg ? cc - CTXL / 32 : cc;
    const int Ls = seg ? SEQ : CTXL, rowbase = seg ? b * SEQ : ML + b * CTXL;
    const int tpos = dir ? (Ls - 1 - (c0 * 32 + pj)) : (c0 * 32 + pj);
    const size_t row = (size_t)(rowbase + tpos);
    const bool vm = tpos > 0, vp = tpos < Ls - 1;
    uint4 rg[3][3];
#pragma unroll
    for (int x = 0; x < 3; ++x) {
      const u16* s0 = PB + row * PBW + (x == 0 ? PB_K : (x == 1 ? PB_V : PB_Q)) + h * 64 + oc * 8;
      rg[x][1] = *reinterpret_cast<const uint4*>(s0);
      rg[x][0] = make_uint4(0, 0, 0, 0); rg[x][2] = make_uint4(0, 0, 0, 0);
      if (vm) rg[x][0] = *reinterpret_cast<const uint4*>(s0 - PBW);
      if (vp) rg[x][2] = *reinterpret_cast<const uint4*>(s0 + PBW);
    }
    float ral = 0.f, rbl = 0.f;
    if (oc == 0) { ral = AB[row * 16 + dir * 4 + h]; rbl = AB[row * 16 + 8 + dir * 4 + h]; }
    float* Lk = Lbase + (cc & 1) * BUFSZ;
    float* Lq = Lk + 32 * 68;
    float* Lv = Lq + 32 * 68;
    float4* Lc = reinterpret_cast<float4*>(Lv + 32 * 68);
    float* LkT = Lk + 3 * 32 * 68 + 160;
#pragma unroll
    for (int x = 0; x < 3; ++x) {
      float y[8];
      float ss = 0.f;
      const unsigned am[4] = {rg[x][0].x, rg[x][0].y, rg[x][0].z, rg[x][0].w};
      const unsigned a0[4] = {rg[x][1].x, rg[x][1].y, rg[x][1].z, rg[x][1].w};
      const unsigned ap[4] = {rg[x][2].x, rg[x][2].y, rg[x][2].z, rg[x][2].w};
      const float4* wq = reinterpret_cast<const float4*>(Lw + x * 192 + oc * 24);
      float wv[24];
#pragma unroll
      for (int i = 0; i < 6; ++i) { const float4 t4 = wq[i]; wv[i * 4] = t4.x; wv[i * 4 + 1] = t4.y; wv[i * 4 + 2] = t4.z; wv[i * 4 + 3] = t4.w; }
#pragma unroll
      for (int e = 0; e < 8; ++e) {
        const float xm = (e & 1) ? hi2f(am[e >> 1]) : lo2f(am[e >> 1]);
        const float x0 = (e & 1) ? hi2f(a0[e >> 1]) : lo2f(a0[e >> 1]);
        const float xp = (e & 1) ? hi2f(ap[e >> 1]) : lo2f(ap[e >> 1]);
        float v = wv[e * 3 + 0] * xm + wv[e * 3 + 1] * x0 + wv[e * 3 + 2] * xp;
        v = silu_f(v);
        y[e] = v;
        ss += v * v;
      }
      if (x != 1) {
        ss = reduce8(ss);
        float sc = rsqrtf(ss + EPS);
        if (x == 2) sc *= 0.125f;
#pragma unroll
        for (int e = 0; e < 8; ++e) y[e] *= sc;
      }
      if (x == 0) {
#pragma unroll
        for (int e = 0; e < 8; ++e) LkT[(oc * 8 + e) * 36 + pj] = y[e];
      }
      float* dst = (x == 0 ? Lk : (x == 1 ? Lv : Lq)) + pj * 68 + oc * 8;
      *reinterpret_cast<float4*>(dst) = make_float4(y[0], y[1], y[2], y[3]);
      *reinterpret_cast<float4*>(dst + 4) = make_float4(y[4], y[5], y[6], y[7]);
    }
    if (oc == 0) { const float gl = Acoef * softplus_f(ral + dtb); Lc[pj] = make_float4(__expf(gl), sigm(rbl), 0.f, gl); }
  };
  auto write_out = [&](int cc) {
    const int seg = cc >= CTXL / 32, c0 = seg ? cc - CTXL / 32 : cc;
    if (!(seg || ctx_out)) return;
    const int Ls = seg ? SEQ : CTXL, rowbase = seg ? b * SEQ : ML + b * CTXL;
    const int tpos = dir ? (Ls - 1 - (c0 * 32 + pj)) : (c0 * 32 + pj);
    const float4 oa = *reinterpret_cast<const float4*>(Lo_base + (cc & 1) * 2048 + pj * 64 + oc * 8);
    const float4 ob = *reinterpret_cast<const float4*>(Lo_base + (cc & 1) * 2048 + pj * 64 + oc * 8 + 4);
    uint4 w; w.x = pack2(oa.x, oa.y); w.y = pack2(oa.z, oa.w); w.z = pack2(ob.x, ob.y); w.w = pack2(ob.z, ob.w);
    *reinterpret_cast<uint4*>(O + (size_t)(rowbase + tpos) * 256 + h * 64 + oc * 8) = w;
  };
  if (wid >= 4) prep_chunk(0);
  __syncthreads();
#pragma unroll 1
  for (int cc = 0; cc < NCH; ++cc) {
    if (wid >= 4) {
      if (cc > 0) write_out(cc - 1);
      if (cc + 1 < NCH) prep_chunk(cc + 1);
    } else {
      float* Lk = Lbase + (cc & 1) * BUFSZ;
      float* Lq = Lk + 32 * 68;
      float* Lv = Lq + 32 * 68;
    {
      float* Lo = Lo_base + (cc & 1) * 2048;
      float* W = Lo_base + 4096 + wid * 1408;
      float* A1 = W; float* A2 = W + 256; float* KSs = W + 512; float* QSs = W + 768; float* DlT = W + 1024;
      float* Cs = W + 1280; float* Ecs = W + 1296; float* E15 = W + 1312; float* Bts = W + 1328;
      const float* LkT = Lk + 3 * 32 * 68 + 160;
      const int fr = lane & 15, fq = lane >> 4, vq = lane >> 2, sq = lane & 3;
      const float4* Lc4 = reinterpret_cast<const float4*>(Lv + 32 * 68);
#pragma unroll 1
      for (int mc = 0; mc < 2; ++mc) {
        const int tb = mc * 16;
        {
          float ct = 0.f, c15 = 0.f;
#pragma unroll
          for (int j = 0; j < 16; ++j) { const float gj = Lc4[tb + j].w; c15 += gj; ct += (j <= fr) ? gj : 0.f; }
          if (lane < 16) { Cs[lane] = ct; Ecs[lane] = __expf(ct); E15[lane] = __expf(c15 - ct); Bts[lane] = Lc4[tb + lane].y; }
        }
        bf16x8 kf[2], qf[2], kp[2], qp[2];
#pragma unroll
        for (int ks = 0; ks < 2; ++ks) {
          const float* kr = Lk + (tb + fr) * 68;
          const float* qr = Lq + (tb + fr) * 68;
          const float4 a0 = *reinterpret_cast<const float4*>(kr + ks * 32 + fq * 8), a1 = *reinterpret_cast<const float4*>(kr + ks * 32 + fq * 8 + 4);
          const float4 b0 = *reinterpret_cast<const float4*>(qr + ks * 32 + fq * 8), b1 = *reinterpret_cast<const float4*>(qr + ks * 32 + fq * 8 + 4);
          const float4 c0 = *reinterpret_cast<const float4*>(kr + (2 * ks) * 16 + fq * 4), c1 = *reinterpret_cast<const float4*>(kr + (2 * ks + 1) * 16 + fq * 4);
          const float4 d0 = *reinterpret_cast<const float4*>(qr + (2 * ks) * 16 + fq * 4), d1 = *reinterpret_cast<const float4*>(qr + (2 * ks + 1) * 16 + fq * 4);
          const uint4 ua = make_uint4(pack2(a0.x, a0.y), pack2(a0.z, a0.w), pack2(a1.x, a1.y), pack2(a1.z, a1.w));
          const uint4 ub = make_uint4(pack2(b0.x, b0.y), pack2(b0.z, b0.w), pack2(b1.x, b1.y), pack2(b1.z, b1.w));
          const uint4 uc = make_uint4(pack2(c0.x, c0.y), pack2(c0.z, c0.w), pack2(c1.x, c1.y), pack2(c1.z, c1.w));
          const uint4 ud = make_uint4(pack2(d0.x, d0.y), pack2(d0.z, d0.w), pack2(d1.x, d1.y), pack2(d1.z, d1.w));
          kf[ks] = __builtin_bit_cast(bf16x8, ua); qf[ks] = __builtin_bit_cast(bf16x8, ub);
          kp[ks] = __builtin_bit_cast(bf16x8, uc); qp[ks] = __builtin_bit_cast(bf16x8, ud);
        }
        f32x4 g1 = f32x4{0.f, 0.f, 0.f, 0.f}, g2 = f32x4{0.f, 0.f, 0.f, 0.f}, ks0 = f32x4{0.f, 0.f, 0.f, 0.f}, qs0 = f32x4{0.f, 0.f, 0.f, 0.f};
#pragma unroll
        for (int ks = 0; ks < 2; ++ks) {
          const uint4 us = make_uint4(pack2(Sacc[2 * ks][0], Sacc[2 * ks][1]), pack2(Sacc[2 * ks][2], Sacc[2 * ks][3]),
                                      pack2(Sacc[2 * ks + 1][0], Sacc[2 * ks + 1][1]), pack2(Sacc[2 * ks + 1][2], Sacc[2 * ks + 1][3]));
          const bf16x8 sf = __builtin_bit_cast(bf16x8, us);
          g1 = __builtin_amdgcn_mfma_f32_16x16x32_bf16(kf[ks], kf[ks], g1, 0, 0, 0);
          g2 = __builtin_amdgcn_mfma_f32_16x16x32_bf16(qf[ks], kf[ks], g2, 0, 0, 0);
          ks0 = __builtin_amdgcn_mfma_f32_16x16x32_bf16(kp[ks], sf, ks0, 0, 0, 0);
          qs0 = __builtin_amdgcn_mfma_f32_16x16x32_bf16(qp[ks], sf, qs0, 0, 0, 0);
        }
        WAVE_SYNC();
        {
          const float cs = Cs[fr];
          const float4 ct4 = *reinterpret_cast<const float4*>(Cs + fq * 4);
          const float4 bt4 = *reinterpret_cast<const float4*>(Bts + fq * 4);
          const float ctv[4] = {ct4.x, ct4.y, ct4.z, ct4.w}, btv[4] = {bt4.x, bt4.y, bt4.z, bt4.w};
#pragma unroll
          for (int i = 0; i < 4; ++i) {
            const int t = fq * 4 + i;
            const float e = __expf(fminf(ctv[i] - cs, 0.f));
            A1[t * 16 + fr] = (fr < t) ? btv[i] * g1[i] * e : 0.f;
            A2[t * 16 + fr] = (fr <= t) ? g2[i] * e : 0.f;
            KSs[t * 16 + fr] = ks0[i];
            QSs[t * 16 + fr] = qs0[i];
          }
        }
        WAVE_SYNC();
        float dreg[4] = {0.f, 0.f, 0.f, 0.f};
        float na1[4], na2[4], nbt, nec, nv, nks, nqs;
#pragma unroll
        for (int j = 0; j < 4; ++j) { na1[j] = A1[sq + 4 * j]; na2[j] = A2[sq + 4 * j]; }
        nbt = Bts[0]; nec = Ecs[0]; nv = Lv[tb * 68 + wid * 16 + vq]; nks = KSs[vq]; nqs = QSs[vq];
#pragma unroll
        for (int t = 0; t < 16; ++t) {
          float a1[4], a2[4];
#pragma unroll
          for (int j = 0; j < 4; ++j) { a1[j] = na1[j]; a2[j] = na2[j]; }
          const float bt = nbt, ec = nec, vv = nv, ksv = nks, qsv = nqs;
          if (t < 15) {
#pragma unroll
            for (int j = 0; j < (t + 4) / 4; ++j) na1[j] = A1[(t + 1) * 16 + sq + 4 * j];
#pragma unroll
            for (int j = 0; j <= ((t + 1) >> 2); ++j) na2[j] = A2[(t + 1) * 16 + sq + 4 * j];
            nbt = Bts[t + 1]; nec = Ecs[t + 1]; nv = Lv[(tb + t + 1) * 68 + wid * 16 + vq]; nks = KSs[(t + 1) * 16 + vq]; nqs = QSs[(t + 1) * 16 + vq];
          }
          float part = 0.f;
#pragma unroll
          for (int j = 0; j < (t + 3) / 4; ++j) part += a1[j] * dreg[j];
          part = reduce4(part);
          const float dt = bt * vv - bt * ec * ksv - part;
          dreg[t >> 2] = (sq == (t & 3)) ? dt : dreg[t >> 2];
          float po = 0.f;
#pragma unroll
          for (int j = 0; j <= (t >> 2); ++j) po += a2[j] * dreg[j];
          po = reduce4(po);
          Lo[(tb + t) * 64 + wid * 16 + vq] = ec * qsv + po;
          DlT[vq * 16 + t] = dt;
        }
        WAVE_SYNC();
        {
          const float Dd = Ecs[15];
          bf16x8 df = {0, 0, 0, 0, 0, 0, 0, 0};
          float4 e0 = make_float4(0.f, 0.f, 0.f, 0.f), e1 = e0;
          if (fq < 2) {
            const float4 x0 = *reinterpret_cast<const float4*>(DlT + fr * 16 + fq * 8), x1 = *reinterpret_cast<const float4*>(DlT + fr * 16 + fq * 8 + 4);
            const uint4 ux = make_uint4(pack2(x0.x, x0.y), pack2(x0.z, x0.w), pack2(x1.x, x1.y), pack2(x1.z, x1.w));
            df = __builtin_bit_cast(bf16x8, ux);
            e0 = *reinterpret_cast<const float4*>(E15 + fq * 8); e1 = *reinterpret_cast<const float4*>(E15 + fq * 8 + 4);
          }
#pragma unroll
          for (int mt = 0; mt < 4; ++mt) {
            bf16x8 kt = {0, 0, 0, 0, 0, 0, 0, 0};
            if (fq < 2) {
              const float4 x0 = *reinterpret_cast<const float4*>(LkT + (mt * 16 + fr) * 36 + tb + fq * 8), x1 = *reinterpret_cast<const float4*>(LkT + (mt * 16 + fr) * 36 + tb + fq * 8 + 4);
              const uint4 ux = make_uint4(pack2(x0.x * e0.x, x0.y * e0.y), pack2(x0.z * e0.z, x0.w * e0.w), pack2(x1.x * e1.x, x1.y * e1.y), pack2(x1.z * e1.z, x1.w * e1.w));
              kt = __builtin_bit_cast(bf16x8, ux);
            }
            f32x4 sc = Sacc[mt];
            sc[0] *= Dd; sc[1] *= Dd; sc[2] *= Dd; sc[3] *= Dd;
            Sacc[mt] = __builtin_amdgcn_mfma_f32_16x16x32_bf16(kt, df, sc, 0, 0, 0);
          }
        }
        WAVE_SYNC();
      }
    }
    }
    __syncthreads();
  }
  if (wid >= 4) write_out(NCH - 1);
}

constexpr int G4_TAB = 640;
constexpr int G4_ROWS = 3 * 32 * 68 + 64 * 36 + 64;
constexpr int G4_TABS = 2 * G4_TAB;
__device__ __forceinline__ void gdn_block4(const Params& p, int l, int b, int h, int dir, char* smem, bool ctx_out) {
  const int tid = tid_l(), lane = tid & 63, wid = tid >> 6;
  float* Lbase = reinterpret_cast<float*>(smem);
  float* Tab_base = Lbase + 3 * G4_ROWS;
  float* Lo_base = Tab_base + 2 * G4_TABS;
  float* Wsc = Lo_base + 4096;
  float* Lw = Wsc + 4 * 768;
  const u16* PB = reinterpret_cast<const u16*>(p.ws + OFF_PB);
  const float* AB = reinterpret_cast<const float*>(p.ws + OFF_AB);
  u16* O = reinterpret_cast<u16*>(p.ws + (dir ? OFF_OGB : OFF_OGF));
  const float Acoef = -__expf(p.in[21][l * 8 + dir * 4 + h]);
  const float dtb = p.in[22][l * 8 + dir * 4 + h];
  const int fr = lane & 15, fq = lane >> 4;
  __syncthreads();
  {
    const float* cw = p.in[20] + (size_t)l * 3 * 256 * 3;
    for (int e = tid; e < 576; e += NT) { const int x = e / 192, r = e - x * 192; Lw[e] = cw[(size_t)(x * 256 + h * 64) * 3 + r]; }
  }
  __syncthreads();
  f32x4 Sacc[4];
#pragma unroll
  for (int i = 0; i < 4; ++i) Sacc[i] = f32x4{0.f, 0.f, 0.f, 0.f};
  constexpr int NCH = (CTXL + SEQ) / 32;
  const int mprep = wid & 1;
  const int t2 = tid & 255, pj = t2 >> 3, oc = t2 & 7;
  uint4 rg[3][3];
  float ral = 0.f, rbl = 0.f;
  auto row_info = [&](int cc, int step, int& Ls, int& tpos) -> size_t {
    const int seg = cc >= CTXL / 32, c0 = seg ? cc - CTXL / 32 : cc;
    Ls = seg ? SEQ : CTXL;
    const int rowbase = seg ? b * SEQ : ML + b * CTXL;
    tpos = dir ? (Ls - 1 - (c0 * 32 + step)) : (c0 * 32 + step);
    return (size_t)(rowbase + tpos);
  };
  auto issue_loads = [&](int cc) {
    int Ls, tpos;
    const size_t row = row_info(cc, pj, Ls, tpos);
    const bool vm = tpos > 0, vp = tpos < Ls - 1;
#pragma unroll
    for (int x = 0; x < 3; ++x) {
      const u16* s0 = PB + row * PBW + (x == 0 ? PB_K : (x == 1 ? PB_V : PB_Q)) + h * 64 + oc * 8;
      rg[x][1] = *reinterpret_cast<const uint4*>(s0);
      rg[x][0] = make_uint4(0, 0, 0, 0); rg[x][2] = make_uint4(0, 0, 0, 0);
      if (vm) rg[x][0] = *reinterpret_cast<const uint4*>(s0 - PBW);
      if (vp) rg[x][2] = *reinterpret_cast<const uint4*>(s0 + PBW);
    }
    if (oc == 0) { ral = AB[row * 16 + dir * 4 + h]; rbl = AB[row * 16 + 8 + dir * 4 + h]; }
  };
  auto prep_rows = [&](int cc) {
    float* Lk = Lbase + (cc % 3) * G4_ROWS;
    float* Lq = Lk + 32 * 68;
    float* Lv = Lq + 32 * 68;
    float* LkT = Lv + 32 * 68;
    float* Gsr = LkT + 64 * 36;
    float* Btr = Gsr + 32;
#pragma unroll
    for (int x = 0; x < 3; ++x) {
      float y[8];
      float ss = 0.f;
      const unsigned am[4] = {rg[x][0].x, rg[x][0].y, rg[x][0].z, rg[x][0].w};
      const unsigned a0[4] = {rg[x][1].x, rg[x][1].y, rg[x][1].z, rg[x][1].w};
      const unsigned ap[4] = {rg[x][2].x, rg[x][2].y, rg[x][2].z, rg[x][2].w};
      const float4* wq = reinterpret_cast<const float4*>(Lw + x * 192 + oc * 24);
      float wv[24];
#pragma unroll
      for (int i = 0; i < 6; ++i) { const float4 t4 = wq[i]; wv[i * 4] = t4.x; wv[i * 4 + 1] = t4.y; wv[i * 4 + 2] = t4.z; wv[i * 4 + 3] = t4.w; }
#pragma unroll
      for (int e = 0; e < 8; ++e) {
        const float xm = (e & 1) ? hi2f(am[e >> 1]) : lo2f(am[e >> 1]);
        const float x0 = (e & 1) ? hi2f(a0[e >> 1]) : lo2f(a0[e >> 1]);
        const float xp = (e & 1) ? hi2f(ap[e >> 1]) : lo2f(ap[e >> 1]);
        float v = wv[e * 3 + 0] * xm + wv[e * 3 + 1] * x0 + wv[e * 3 + 2] * xp;
        v = silu_f(v);
        y[e] = v;
        ss += v * v;
      }
      if (x != 1) {
        ss = reduce8(ss);
        float sc = rsqrtf(ss + EPS);
        if (x == 2) sc *= 0.125f;
#pragma unroll
        for (int e = 0; e < 8; ++e) y[e] *= sc;
      }
      if (x == 0) {
#pragma unroll
        for (int e = 0; e < 8; ++e) LkT[(oc * 8 + e) * 36 + pj] = y[e];
      }
      float* dst = (x == 0 ? Lk : (x == 1 ? Lv : Lq)) + pj * 68 + oc * 8;
      *reinterpret_cast<float4*>(dst) = make_float4(y[0], y[1], y[2], y[3]);
      *reinterpret_cast<float4*>(dst + 4) = make_float4(y[4], y[5], y[6], y[7]);
    }
    if (oc == 0) { Gsr[pj] = Acoef * softplus_f(ral + dtb); Btr[pj] = sigm(rbl); }
  };
  auto build_tables = [&](int cc) {
    const float* Lk = Lbase + (cc % 3) * G4_ROWS;
    const float* Lq = Lk + 32 * 68;
    const float* Gsr = Lk + 3 * 32 * 68 + 64 * 36;
    const float* Btr = Gsr + 32;
    float* T = Tab_base + (cc & 1) * G4_TABS + mprep * G4_TAB;
    float* A1 = T; float* A2 = T + 256; float* Ecs = T + 512; float* E15 = T + 528; float* Bts = T + 544; float* Cs = T + 560;
    const int tb = mprep * 16, st = tb + fr;
    {
      float ct = 0.f, c15 = 0.f;
#pragma unroll
      for (int j = 0; j < 16; ++j) { const float gj = Gsr[tb + j]; c15 += gj; ct += (j <= fr) ? gj : 0.f; }
      if (lane < 16) { Cs[lane] = ct; Ecs[lane] = __expf(ct); E15[lane] = __expf(c15 - ct); Bts[lane] = Btr[tb + lane]; }
    }
    f32x4 g1 = f32x4{0.f, 0.f, 0.f, 0.f}, g2 = f32x4{0.f, 0.f, 0.f, 0.f};
#pragma unroll
    for (int ks = 0; ks < 2; ++ks) {
      const float* kr = Lk + st * 68 + ks * 32 + fq * 8;
      const float* qr = Lq + st * 68 + ks * 32 + fq * 8;
      const float4 a0 = *reinterpret_cast<const float4*>(kr), a1 = *reinterpret_cast<const float4*>(kr + 4);
      const float4 b0 = *reinterpret_cast<const float4*>(qr), b1 = *reinterpret_cast<const float4*>(qr + 4);
      const uint4 ua = make_uint4(pack2(a0.x, a0.y), pack2(a0.z, a0.w), pack2(a1.x, a1.y), pack2(a1.z, a1.w));
      const uint4 ub = make_uint4(pack2(b0.x, b0.y), pack2(b0.z, b0.w), pack2(b1.x, b1.y), pack2(b1.z, b1.w));
      const bf16x8 kf = __builtin_bit_cast(bf16x8, ua), qf = __builtin_bit_cast(bf16x8, ub);
      g1 = __builtin_amdgcn_mfma_f32_16x16x32_bf16(kf, kf, g1, 0, 0, 0);
      g2 = __builtin_amdgcn_mfma_f32_16x16x32_bf16(qf, kf, g2, 0, 0, 0);
    }
    WAVE_SYNC();
    {
      const float cs = Cs[fr];
      const float4 ct4 = *reinterpret_cast<const float4*>(Cs + fq * 4);
      const float4 bt4 = *reinterpret_cast<const float4*>(Bts + fq * 4);
      const float ctv[4] = {ct4.x, ct4.y, ct4.z, ct4.w}, btv[4] = {bt4.x, bt4.y, bt4.z, bt4.w};
#pragma unroll
      for (int i = 0; i < 4; ++i) {
        const int t = fq * 4 + i;
        const float e = __expf(fminf(ctv[i] - cs, 0.f));
        A1[t * 16 + fr] = (fr < t) ? btv[i] * g1[i] * e : 0.f;
        A2[t * 16 + fr] = (fr <= t) ? g2[i] * e : 0.f;
      }
    }
  };
  auto write_out = [&](int cc) {
    const int t3 = tid - 384, pj = t3 >> 2, oc4 = t3 & 3;
    int Ls, tpos;
    const size_t row = row_info(cc, pj, Ls, tpos);
    if (!((cc >= CTXL / 32) || ctx_out)) return;
    const float* s = Lo_base + (cc & 1) * 2048 + pj * 64 + oc4 * 16;
#pragma unroll
    for (int hh = 0; hh < 2; ++hh) {
      const float4 oa = *reinterpret_cast<const float4*>(s + hh * 8), ob = *reinterpret_cast<const float4*>(s + hh * 8 + 4);
      uint4 w; w.x = pack2(oa.x, oa.y); w.y = pack2(oa.z, oa.w); w.z = pack2(ob.x, ob.y); w.w = pack2(ob.z, ob.w);
      *reinterpret_cast<uint4*>(O + row * 256 + h * 64 + oc4 * 16 + hh * 8) = w;
    }
  };
  if (wid >= 4) { issue_loads(0); prep_rows(0); issue_loads(1); }
  __syncthreads();
  if (wid >= 4) { prep_rows(1); issue_loads(2); }
  if (wid == 4 || wid == 5) build_tables(0);
  __syncthreads();
#pragma unroll 1
  for (int cc = 0; cc < NCH; ++cc) {
    if (wid >= 4) {
      if (cc + 2 < NCH) { prep_rows(cc + 2); if (cc + 3 < NCH) issue_loads(cc + 3); }
      if (wid < 6) { if (cc + 1 < NCH) build_tables(cc + 1); }
      else { if (cc > 0) write_out(cc - 1); }
    } else {
      float* Lk = Lbase + (cc % 3) * G4_ROWS;
      float* Lq = Lk + 32 * 68;
      float* Lv = Lq + 32 * 68;
      const float* LkT = Lv + 32 * 68;
      float* Lo = Lo_base + (cc & 1) * 2048;
      float* KSs = Wsc + wid * 768; float* QSs = KSs + 256; float* DlT = KSs + 512;
      const int vq = lane >> 2, sq = lane & 3;
#pragma unroll 1
      for (int mc = 0; mc < 2; ++mc) {
        const int tb = mc * 16;
        const float* T = Tab_base + (cc & 1) * G4_TABS + mc * G4_TAB;
        const float* A1 = T; const float* A2 = T + 256; const float* Ecs = T + 512; const float* E15 = T + 528; const float* Bts = T + 544;
        f32x4 ks0 = f32x4{0.f, 0.f, 0.f, 0.f}, qs0 = f32x4{0.f, 0.f, 0.f, 0.f};
#pragma unroll
        for (int ks = 0; ks < 2; ++ks) {
          const float* kr = Lk + (tb + fr) * 68;
          const float* qr = Lq + (tb + fr) * 68;
          const float4 c0 = *reinterpret_cast<const float4*>(kr + (2 * ks) * 16 + fq * 4), c1 = *reinterpret_cast<const float4*>(kr + (2 * ks + 1) * 16 + fq * 4);
          const float4 d0 = *reinterpret_cast<const float4*>(qr + (2 * ks) * 16 + fq * 4), d1 = *reinterpret_cast<const float4*>(qr + (2 * ks + 1) * 16 + fq * 4);
          const uint4 uc = make_uint4(pack2(c0.x, c0.y), pack2(c0.z, c0.w), pack2(c1.x, c1.y), pack2(c1.z, c1.w));
          const uint4 ud = make_uint4(pack2(d0.x, d0.y), pack2(d0.z, d0.w), pack2(d1.x, d1.y), pack2(d1.z, d1.w));
          const uint4 us = make_uint4(pack2(Sacc[2 * ks][0], Sacc[2 * ks][1]), pack2(Sacc[2 * ks][2], Sacc[2 * ks][3]),
                                      pack2(Sacc[2 * ks + 1][0], Sacc[2 * ks + 1][1]), pack2(Sacc[2 * ks + 1][2], Sacc[2 * ks + 1][3]));
          const bf16x8 sf = __builtin_bit_cast(bf16x8, us);
          ks0 = __builtin_amdgcn_mfma_f32_16x16x32_bf16(__builtin_bit_cast(bf16x8, uc), sf, ks0, 0, 0, 0);
          qs0 = __builtin_amdgcn_mfma_f32_16x16x32_bf16(__builtin_bit_cast(bf16x8, ud), sf, qs0, 0, 0, 0);
        }
#pragma unroll
        for (int i = 0; i < 4; ++i) { KSs[(fq * 4 + i) * 16 + fr] = ks0[i]; QSs[(fq * 4 + i) * 16 + fr] = qs0[i]; }
        WAVE_SYNC();
        float dreg[4] = {0.f, 0.f, 0.f, 0.f};
        float na1[4], na2[4], nbt, nec, nv, nks, nqs;
#pragma unroll
        for (int j = 0; j < 4; ++j) { na1[j] = A1[sq + 4 * j]; na2[j] = A2[sq + 4 * j]; }
        nbt = Bts[0]; nec = Ecs[0]; nv = Lv[tb * 68 + wid * 16 + vq]; nks = KSs[vq]; nqs = QSs[vq];
#pragma unroll
        for (int t = 0; t < 16; ++t) {
          float a1[4], a2[4];
#pragma unroll
          for (int j = 0; j < 4; ++j) { a1[j] = na1[j]; a2[j] = na2[j]; }
          const float bt = nbt, ec = nec, vv = nv, ksv = nks, qsv = nqs;
          if (t < 15) {
#pragma unroll
            for (int j = 0; j < (t + 4) / 4; ++j) na1[j] = A1[(t + 1) * 16 + sq + 4 * j];
#pragma unroll
            for (int j = 0; j <= ((t + 1) >> 2); ++j) na2[j] = A2[(t + 1) * 16 + sq + 4 * j];
            nbt = Bts[t + 1]; nec = Ecs[t + 1]; nv = Lv[(tb + t + 1) * 68 + wid * 16 + vq]; nks = KSs[(t + 1) * 16 + vq]; nqs = QSs[(t + 1) * 16 + vq];
          }
          float part = 0.f;
#pragma unroll
          for (int j = 0; j < (t + 3) / 4; ++j) part += a1[j] * dreg[j];
          part = reduce4(part);
          const float dt = bt * vv - bt * ec * ksv - part;
          dreg[t >> 2] = (sq == (t & 3)) ? dt : dreg[t >> 2];
          float po = 0.f;
#pragma unroll
          for (int j = 0; j <= (t >> 2); ++j) po += a2[j] * dreg[j];
          po = reduce4(po);
          Lo[(tb + t) * 64 + wid * 16 + vq] = ec * qsv + po;
          DlT[vq * 16 + t] = dt;
        }
        WAVE_SYNC();
        {
          const float Dd = Ecs[15];
          bf16x8 df = {0, 0, 0, 0, 0, 0, 0, 0};
          float4 e0 = make_float4(0.f, 0.f, 0.f, 0.f), e1 = e0;
          if (fq < 2) {
            const float4 x0 = *reinterpret_cast<const float4*>(DlT + fr * 16 + fq * 8), x1 = *reinterpret_cast<const float4*>(DlT + fr * 16 + fq * 8 + 4);
            const uint4 ux = make_uint4(pack2(x0.x, x0.y), pack2(x0.z, x0.w), pack2(x1.x, x1.y), pack2(x1.z, x1.w));
            df = __builtin_bit_cast(bf16x8, ux);
            e0 = *reinterpret_cast<const float4*>(E15 + fq * 8); e1 = *reinterpret_cast<const float4*>(E15 + fq * 8 + 4);
          }
#pragma unroll
          for (int mt = 0; mt < 4; ++mt) {
            bf16x8 kt = {0, 0, 0, 0, 0, 0, 0, 0};
            if (fq < 2) {
              const float4 x0 = *reinterpret_cast<const float4*>(LkT + (mt * 16 + fr) * 36 + tb + fq * 8), x1 = *reinterpret_cast<const float4*>(LkT + (mt * 16 + fr) * 36 + tb + fq * 8 + 4);
              const uint4 ux = make_uint4(pack2(x0.x * e0.x, x0.y * e0.y), pack2(x0.z * e0.z, x0.w * e0.w), pack2(x1.x * e1.x, x1.y * e1.y), pack2(x1.z * e1.z, x1.w * e1.w));
              kt = __builtin_bit_cast(bf16x8, ux);
            }
            f32x4 sc = Sacc[mt];
            sc[0] *= Dd; sc[1] *= Dd; sc[2] *= Dd; sc[3] *= Dd;
            Sacc[mt] = __builtin_amdgcn_mfma_f32_16x16x32_bf16(kt, df, sc, 0, 0, 0);
          }
        }
        WAVE_SYNC();
      }
    }
    __syncthreads();
  }
  if (wid >= 6) write_out(NCH - 1);
}

__device__ __forceinline__ void s5_wave(const Params& p, int l, int b, int g, int dir, char* Lw, bool ctx_out) {
  const int lane = tid_l() & 63, fr = lane & 15, fq = lane >> 4;
  u16* Ubf = reinterpret_cast<u16*>(Lw);
  float* Bu = reinterpret_cast<float*>(Lw + 512);
  u16* Sbf = reinterpret_cast<u16*>(Lw + 512 + 8448);
  const u16* PB = reinterpret_cast<const u16*>(p.ws + OFF_PB);
  u16* O = reinterpret_cast<u16*>(p.ws + (dir ? OFF_O5B : OFF_O5F));
  const int gi = (l * 2 + dir) * 16 + g;
  const float dt = expf(p.in[11][gi]);
  float a_re, a_im;
  {
    const float lr = p.in[9][gi * 64 + lane], li = p.in[10][gi * 64 + lane];
    const float mag = expf(lr * dt);
    float sn, cs;
    sincosf(li * dt, &sn, &cs);
    a_re = mag * cs; a_im = mag * sn;
  }
  bf16x8 Af[8];
#pragma unroll
  for (int mt = 0; mt < 8; ++mt) {
    const int m = mt * 16 + fr, pp = m >> 1, ri = m & 1;
    bf16x8 v = {0, 0, 0, 0, 0, 0, 0, 0};
    if (fq < 2) {
      const float lr = p.in[9][gi * 64 + pp], li = p.in[10][gi * 64 + pp];
      const float mag = expf(lr * dt);
      float sn, cs;
      sincosf(li * dt, &sn, &cs);
      const float xr = mag * cs - 1.f, xi = mag * sn;
      const float den = lr * lr + li * li;
      const float cr = (xr * lr + xi * li) / den, ci = (xi * lr - xr * li) / den;
      const float4* brp = reinterpret_cast<const float4*>(p.in[12] + (size_t)(gi * 64 + pp) * 16 + fq * 8);
      const float4* bip = reinterpret_cast<const float4*>(p.in[13] + (size_t)(gi * 64 + pp) * 16 + fq * 8);
      const float4 r0 = brp[0], r1 = brp[1], i0 = bip[0], i1 = bip[1];
      const float br[8] = {r0.x, r0.y, r0.z, r0.w, r1.x, r1.y, r1.z, r1.w};
      const float bi[8] = {i0.x, i0.y, i0.z, i0.w, i1.x, i1.y, i1.z, i1.w};
#pragma unroll
      for (int e = 0; e < 8; ++e) {
        const float val = ri ? (cr * bi[e] + ci * br[e]) : (cr * br[e] - ci * bi[e]);
        v[e] = (short)f2bf(val);
      }
    }
    Af[mt] = v;
  }
  bf16x8 Cf[4];
#pragma unroll
  for (int ks = 0; ks < 4; ++ks) {
    const size_t ci = (size_t)(gi * 16 + fr) * 64 + ks * 16 + fq * 4;
    const float4 cre = *reinterpret_cast<const float4*>(p.in[14] + ci);
    const float4 cim = *reinterpret_cast<const float4*>(p.in[15] + ci);
    bf16x8 v;
    v[0] = (short)f2bf(cre.x); v[1] = (short)f2bf(-cim.x); v[2] = (short)f2bf(cre.y); v[3] = (short)f2bf(-cim.y);
    v[4] = (short)f2bf(cre.z); v[5] = (short)f2bf(-cim.z); v[6] = (short)f2bf(cre.w); v[7] = (short)f2bf(-cim.w);
    Cf[ks] = v;
  }
  float sr = 0.f, si = 0.f;
  constexpr int NCH = (CTXL + SEQ) / 16, NCC = CTXL / 16;
  auto row_of = [&](int cc, int j) -> size_t {
    const int seg = cc >= NCC, c0 = seg ? cc - NCC : cc;
    const int Ls = seg ? SEQ : CTXL, rowbase = seg ? b * SEQ : ML + b * CTXL;
    const int tpos = dir ? (Ls - 1 - (c0 * 16 + j)) : (c0 * 16 + j);
    return (size_t)(rowbase + tpos);
  };
  uint4 ucur = make_uint4(0, 0, 0, 0), unxt = make_uint4(0, 0, 0, 0);
  if (fq < 2) {
    ucur = *reinterpret_cast<const uint4*>(PB + row_of(0, fr) * PBW + g * 16 + fq * 8);
    unxt = *reinterpret_cast<const uint4*>(PB + row_of(1, fr) * PBW + g * 16 + fq * 8);
  }
  auto project = [&](const uint4& uu) {
    const bf16x8 ub = __builtin_bit_cast(bf16x8, uu);
#pragma unroll
    for (int mt = 0; mt < 8; ++mt) {
      const f32x4 r = __builtin_amdgcn_mfma_f32_16x16x32_bf16(Af[mt], ub, f32x4{0.f, 0.f, 0.f, 0.f}, 0, 0, 0);
      *reinterpret_cast<float4*>(Bu + fr * 132 + mt * 16 + fq * 4) = make_float4(r[0], r[1], r[2], r[3]);
    }
  };
  auto readout = [&](int cc) {
    if (!((cc >= NCC) || ctx_out)) return;
    const u16* Sb = Sbf + (cc & 1) * 2176;
    f32x4 y = f32x4{0.f, 0.f, 0.f, 0.f};
#pragma unroll
    for (int ks = 0; ks < 4; ++ks) {
      const bf16x8 sa = *reinterpret_cast<const bf16x8*>(Sb + fr * 136 + ks * 32 + fq * 8);
      y = __builtin_amdgcn_mfma_f32_16x16x32_bf16(Cf[ks], sa, y, 0, 0, 0);
    }
    uint2 w;
    w.x = pack2(y[0], y[1]); w.y = pack2(y[2], y[3]);
    *reinterpret_cast<uint2*>(O + row_of(cc, fr) * 256 + g * 16 + fq * 4) = w;
  };
  project(ucur);
#pragma unroll 1
  for (int cc = 0; cc < NCH; ++cc) {
    WAVE_SYNC();
    float2 buv[16];
#pragma unroll
    for (int j = 0; j < 16; ++j) buv[j] = *reinterpret_cast<const float2*>(Bu + j * 132 + 2 * lane);
    WAVE_SYNC();
    if (cc + 1 < NCH) project(unxt);
    if (fq < 2 && cc + 2 < NCH) unxt = *reinterpret_cast<const uint4*>(PB + row_of(cc + 2, fr) * PBW + g * 16 + fq * 8);
    if (cc > 0) readout(cc - 1);
    u16* Sc = Sbf + (cc & 1) * 2176;
#pragma unroll
    for (int j = 0; j < 16; ++j) {
      const float nr = fmaf(a_re, sr, fmaf(-a_im, si, buv[j].x));
      const float ni = fmaf(a_re, si, fmaf(a_im, sr, buv[j].y));
      sr = nr; si = ni;
      *reinterpret_cast<unsigned*>(Sc + j * 136 + 2 * lane) = pack2(sr, si);
    }
  }
  WAVE_SYNC();
  readout(NCH - 1);
}

__device__ __forceinline__ void sgu_item(const Params& p, int l, int rowbase, int g, char* smem) {
  const int tid = tid_l(), lane = tid & 63, wid = tid >> 6, fr = lane & 15, fq = lane >> 4;
  const u16* PB = reinterpret_cast<const u16*>(p.ws + OFF_PB);
  u16* Y = reinterpret_cast<u16*>(p.ws + OFF_Y);
  u16* vT = reinterpret_cast<u16*>(smem);
  __syncthreads();
  {
    const int q = tid >> 2, qt = tid & 3;
    const u16* src = PB + (size_t)(rowbase + q) * PBW + PB_VSG + g * 64 + qt * 16;
    float v[16];
    float s = 0.f;
#pragma unroll
    for (int i = 0; i < 2; ++i) {
      const uint4 r = *reinterpret_cast<const uint4*>(src + i * 8);
      const unsigned a[4] = {r.x, r.y, r.z, r.w};
#pragma unroll
      for (int e = 0; e < 4; ++e) {
        v[i * 8 + e * 2] = gelu_t(lo2f(a[e]));
        v[i * 8 + e * 2 + 1] = gelu_t(hi2f(a[e]));
        s += v[i * 8 + e * 2] + v[i * 8 + e * 2 + 1];
      }
    }
    s += __shfl_xor(s, 1);
    s += __shfl_xor(s, 2);
    const float mu = s * (1.f / 64.f);
    float vs = 0.f;
#pragma unroll
    for (int i = 0; i < 16; ++i) { const float d = v[i] - mu; vs += d * d; }
    vs += __shfl_xor(vs, 1);
    vs += __shfl_xor(vs, 2);
    const float rs = rsqrtf(vs * (1.f / 64.f) + EPS);
    const float* lg = p.in[24] + l * 256 + g * 64 + qt * 16;
    const float* lb = p.in[25] + l * 256 + g * 64 + qt * 16;
#pragma unroll
    for (int i = 0; i < 16; ++i) {
      const float o = (v[i] - mu) * rs * lg[i] + lb[i];
      vT[(qt * 16 + i) * 136 + q] = f2bf(o);
    }
  }
  __syncthreads();
  const u16* Wg = reinterpret_cast<const u16*>(p.ws + OFF_SGW) + (size_t)(l * 4 + g) * 128 * 128;
  f32x4 acc[4];
#pragma unroll
  for (int n = 0; n < 4; ++n) acc[n] = f32x4{0.f, 0.f, 0.f, 0.f};
#pragma unroll
  for (int ks = 0; ks < 4; ++ks) {
    const bf16x8 a = *reinterpret_cast<const bf16x8*>(Wg + (size_t)(wid * 16 + fr) * 128 + ks * 32 + fq * 8);
#pragma unroll
    for (int n = 0; n < 4; ++n) {
      const bf16x8 bb = *reinterpret_cast<const bf16x8*>(vT + (n * 16 + fr) * 136 + ks * 32 + fq * 8);
      acc[n] = __builtin_amdgcn_mfma_f32_16x16x32_bf16(a, bb, acc[n], 0, 0, 0);
    }
  }
  const float* sgb = p.in[27] + (size_t)(l * 4 + g) * 128;
#pragma unroll
  for (int n = 0; n < 4; ++n)
#pragma unroll
    for (int j = 0; j < 4; ++j) {
      const int pp = wid * 16 + fq * 4 + j, c = n * 16 + fr;
      const size_t row = (size_t)(rowbase + pp);
      const float u = gelu_t(bf2f(PB[row * PBW + PB_USG + g * 64 + c]));
      Y[row * 1024 + 768 + g * 64 + c] = f2bf(u * (acc[n][j] + sgb[pp]));
    }
}

__device__ __forceinline__ void phase_mix(const Params& p, int l, char* smem) {
  const bool ctx_out = l < DEPTH - 1;
  u16* Y = reinterpret_cast<u16*>(p.ws + OFF_Y);
  {
    SchedStd S;
    S.init(8, 32, 4096, p.ws + OFF_DL, (size_t)256 * 4096 * 2, p.ws + OFF_FT, (size_t)256 * 4096 * 2);
    EpiFnet E; E.Y = Y; E.rowbase = 0; E.rows_per_b = SEQ;
    gemm_phase((PG8_LAS unsigned char*)(smem), 4096, 4096, S, E);
  }
  int* cnt = reinterpret_cast<int*>(p.ws + OFF_CNT) + l;
  volatile int* s_item = reinterpret_cast<volatile int*>(smem + SMALL_OFF);
  const int N_GDN = 256, N_S5 = 128, N_SL = 2048, N_SC = 256, N_FC = 64;
  const int total = N_GDN + N_S5 + N_SL + (ctx_out ? (N_SC + N_FC) : 0);
  for (;;) {
    const int tid = tid_l(), wid = tid >> 6;
    __syncthreads();
    if (tid == 0) *s_item = atomicAdd(cnt, 1);
    __syncthreads();
    int it = *s_item;
    if (it >= total) break;
    if (it < N_GDN) {
      gdn_block4(p, l, (it >> 2) & 31, it & 3, it >> 7, smem, ctx_out);
      continue;
    }
    it -= N_GDN;
    if (it < N_S5) {
      const int b8 = it & 3, g = (it >> 2) & 15, dir = it >> 6;
      s5_wave(p, l, b8 * 8 + wid, g, dir, smem + wid * 17664, ctx_out);
      continue;
    }
    it -= N_S5;
    if (it < N_SL) {
      const int g = it & 3, n = (it >> 2) & 15, b = it >> 6;
      sgu_item(p, l, b * SEQ + n * 128, g, smem);
      continue;
    }
    it -= N_SL;
    if (it < N_SC) {
      const int g = it & 3, n = (it >> 2) & 1, b = it >> 3;
      sgu_item(p, l, ML + b * CTXL + n * 128, g, smem);
      continue;
    }
    it -= N_SC;
    {
      const int grp = tid >> 8, t2 = tid & 255, lane = t2 & 63, w4 = t2 >> 6, wr = w4 >> 1, wc = w4 & 1, fr = lane & 15, fq = lane >> 4;
      const int b = it >> 1, mt = it & 1, nt = grp;
      f32x4 acc[4][4];
      zero_acc<4>(acc);
      gemm_tile<4>(reinterpret_cast<const u16*>(p.ws + OFF_DC) + (size_t)mt * 128 * 512, 512,
                   reinterpret_cast<const u16*>(p.ws + OFF_FTC) + (size_t)(b * 256 + nt * 128) * 512, 512, 512, acc, smem + grp * 32768);
#pragma unroll
      for (int m = 0; m < 4; ++m)
#pragma unroll
        for (int n = 0; n < 4; ++n)
#pragma unroll
          for (int j = 0; j < 4; ++j) {
            const size_t row = (size_t)ML + b * CTXL + mt * 128 + wr * 64 + m * 16 + fq * 4 + j;
            Y[row * 1024 + 256 + nt * 128 + wc * 64 + n * 16 + fr] = f2bf(acc[m][n][j]);
          }
    }
  }
}

__device__ __forceinline__ void phase_fin(const Params& p, int l, int Mrows, char* smem) {
  const int tid = tid_l(), lane = tid & 63, wid = tid >> 6, fr = lane & 15, fq = lane >> 4;
  const u16* PB = reinterpret_cast<const u16*>(p.ws + OFF_PB);
  const u16* O5F = reinterpret_cast<const u16*>(p.ws + OFF_O5F);
  const u16* O5B = reinterpret_cast<const u16*>(p.ws + OFF_O5B);
  const u16* OGF = reinterpret_cast<const u16*>(p.ws + OFF_OGF);
  const u16* OGB = reinterpret_cast<const u16*>(p.ws + OFF_OGB);
  u16* Y = reinterpret_cast<u16*>(p.ws + OFF_Y);
  const u16* GluT = reinterpret_cast<const u16*>(p.ws + OFF_W) + (size_t)l * LAYER_W + GLU_OFF;
  u16* Gs = reinterpret_cast<u16*>(smem);
  u16* At = reinterpret_cast<u16*>(smem) + 256 * 264;
  const float* gain = p.in[23] + l * 64;
  const float* dsk = p.in[16] + l * 256;
  const float* glb = p.in[18] + l * 256;
  __syncthreads();
  for (int e = tid; e < 256 * 32; e += NT) {
    const int n = e >> 5, c8 = (e & 31) * 8;
    *reinterpret_cast<uint4*>(Gs + n * 264 + c8) = *reinterpret_cast<const uint4*>(GluT + (size_t)n * 256 + c8);
  }
  const int items = Mrows / 32;
  uint2 gf[4], gb[4], gz[4], yf[4], yb[4], yu[4];
  auto load_item = [&](int it) {
    const int r0 = it * 32;
#pragma unroll
    for (int k = 0; k < 4; ++k) {
      const size_t row = (size_t)(r0 + wid + k * NW);
      gf[k] = *reinterpret_cast<const uint2*>(OGF + row * 256 + lane * 4);
      gb[k] = *reinterpret_cast<const uint2*>(OGB + row * 256 + lane * 4);
      gz[k] = *reinterpret_cast<const uint2*>(PB + row * PBW + PB_Z + lane * 4);
      const int e = tid + k * NT, rr = e >> 6, c4 = (e & 63) * 4;
      const size_t row2 = (size_t)(r0 + rr);
      yf[k] = *reinterpret_cast<const uint2*>(O5F + row2 * 256 + c4);
      yb[k] = *reinterpret_cast<const uint2*>(O5B + row2 * 256 + c4);
      yu[k] = *reinterpret_cast<const uint2*>(PB + row2 * PBW + c4);
    }
  };
  if ((int)blockIdx.x < items) load_item(blockIdx.x);
  for (int it = blockIdx.x; it < items; it += gridDim.x) {
    const int r0 = it * 32;
    __syncthreads();
#pragma unroll
    for (int k = 0; k < 4; ++k) {
      const size_t row = (size_t)(r0 + wid + k * NW);
      const uint2 f = gf[k], bq = gb[k], z = gz[k];
      float o[4] = {lo2f(f.x) + lo2f(bq.x), hi2f(f.x) + hi2f(bq.x), lo2f(f.y) + lo2f(bq.y), hi2f(f.y) + hi2f(bq.y)};
      float ss = o[0] * o[0] + o[1] * o[1] + o[2] * o[2] + o[3] * o[3];
      ss = reduce16(ss);
      const float rs = rsqrtf(ss * (1.f / 64.f) + EPS);
      const float4 gn = *reinterpret_cast<const float4*>(gain + (lane & 15) * 4);
      const float zz[4] = {lo2f(z.x), hi2f(z.x), lo2f(z.y), hi2f(z.y)};
      const float gg[4] = {gn.x, gn.y, gn.z, gn.w};
      float r[4];
#pragma unroll
      for (int i = 0; i < 4; ++i) r[i] = o[i] * rs * gg[i] * silu_f(zz[i]);
      uint2 w;
      w.x = pack2(r[0], r[1]); w.y = pack2(r[2], r[3]);
      *reinterpret_cast<uint2*>(Y + row * 1024 + 512 + lane * 4) = w;
    }
#pragma unroll
    for (int k = 0; k < 4; ++k) {
      const int e = tid + k * NT, rr = e >> 6, c4 = (e & 63) * 4;
      const uint2 f = yf[k], bq = yb[k], u = yu[k];
      const float4 d4 = *reinterpret_cast<const float4*>(dsk + c4);
      const float y0 = gelu_t(lo2f(f.x) + lo2f(bq.x) + d4.x * lo2f(u.x));
      const float y1 = gelu_t(hi2f(f.x) + hi2f(bq.x) + d4.y * hi2f(u.x));
      const float y2 = gelu_t(lo2f(f.y) + lo2f(bq.y) + d4.z * lo2f(u.y));
      const float y3 = gelu_t(hi2f(f.y) + hi2f(bq.y) + d4.w * hi2f(u.y));
      uint2 w;
      w.x = pack2(y0, y1); w.y = pack2(y2, y3);
      *reinterpret_cast<uint2*>(At + rr * 264 + c4) = w;
    }
    if (it + (int)gridDim.x < items) load_item(it + gridDim.x);
    __syncthreads();
    f32x4 acc[2][2];
#pragma unroll
    for (int m = 0; m < 2; ++m)
#pragma unroll
      for (int n = 0; n < 2; ++n) acc[m][n] = f32x4{0.f, 0.f, 0.f, 0.f};
#pragma unroll
    for (int ks = 0; ks < 8; ++ks) {
      bf16x8 a[2], g[2];
#pragma unroll
      for (int m = 0; m < 2; ++m) a[m] = *reinterpret_cast<const bf16x8*>(At + (m * 16 + fr) * 264 + ks * 32 + fq * 8);
#pragma unroll
      for (int n = 0; n < 2; ++n) g[n] = *reinterpret_cast<const bf16x8*>(Gs + (wid * 32 + n * 16 + fr) * 264 + ks * 32 + fq * 8);
#pragma unroll
      for (int m = 0; m < 2; ++m)
#pragma unroll
        for (int n = 0; n < 2; ++n) acc[m][n] = __builtin_amdgcn_mfma_f32_16x16x32_bf16(g[n], a[m], acc[m][n], 0, 0, 0);
    }
#pragma unroll
    for (int m = 0; m < 2; ++m)
#pragma unroll
      for (int n = 0; n < 2; ++n) {
        const int rr = m * 16 + fr, col = wid * 32 + n * 16 + fq * 4;
        const uint2 yv = *reinterpret_cast<const uint2*>(At + rr * 264 + col);
        const float4 b4 = *reinterpret_cast<const float4*>(glb + col);
        uint2 w;
        w.x = pack2(lo2f(yv.x) * sigm(acc[m][n][0] + b4.x), hi2f(yv.x) * sigm(acc[m][n][1] + b4.y));
        w.y = pack2(lo2f(yv.y) * sigm(acc[m][n][2] + b4.z), hi2f(yv.y) * sigm(acc[m][n][3] + b4.w));
        *reinterpret_cast<uint2*>(Y + (size_t)(r0 + rr) * 1024 + col) = w;
      }
  }
}

struct SchedGM {
  int nM, nsuper, G, c;
  const char* Y; const char* H; const char* Wb; const char* Wg;
  __device__ __forceinline__ bool next(int i, Unit& u) const {
    const int j = i >> 3, s = i & 7;
    const long L = (long)j * G + c;
    if (L >= nsuper) return false;
    int wgid = (int)L;
    { const int q = nsuper / G_NXCD, r = nsuper % G_NXCD, xcd = wgid % G_NXCD, off = wgid / G_NXCD; wgid = (xcd < r ? xcd * (q + 1) : r * (q + 1) + (xcd - r) * q) + off; }
    const int nig = G_WGM * 4, gid = wgid / nig, fm = gid * G_WGM, gsz = (nM - fm) < G_WGM ? (nM - fm) : G_WGM;
    u.pm = fm + ((wgid % nig) % gsz);
    u.pn = ((wgid % nig) / gsz) * 8 + s;
    return true;
  }
  __device__ __forceinline__ const char* aptr(const Unit& u) const {
    const int s = u.pn & 7;
    return (s < 4) ? Y + (size_t)u.pm * (256 * 1024 * 2) + s * 512 : H + (size_t)u.pm * (256 * 1024 * 2);
  }
  __device__ __forceinline__ const char* bptr(const Unit& u) const {
    const int s = u.pn & 7, dq = u.pn >> 3;
    return (s < 4) ? Wb + (size_t)dq * (256 * 1024 * 2) + s * 512 : Wg + (size_t)(dq * 4 + (s - 4)) * (256 * 1024 * 2);
  }
  __device__ __forceinline__ int kt(const Unit& u) const { return ((u.pn & 7) < 4) ? 4 : 16; }
};
struct EpiGM {
  uint4* brs;
  u16* ACC;
  __device__ __forceinline__ void operator()(const f32x4 (&acc)[2][2][4][2], const Unit& u, int wr, int wc, int fr, int fq) const {
    const int s = u.pn & 7, dq = u.pn >> 3;
    const int tid = tid_l();
    if (s < 4) {
#pragma unroll
      for (int ai = 0; ai < 2; ++ai)
#pragma unroll
        for (int bj = 0; bj < 2; ++bj)
#pragma unroll
          for (int m = 0; m < 4; ++m) {
            uint4 w;
            w.x = pack2(acc[ai][bj][m][0][0], acc[ai][bj][m][0][1]); w.y = pack2(acc[ai][bj][m][0][2], acc[ai][bj][m][0][3]);
            w.z = pack2(acc[ai][bj][m][1][0], acc[ai][bj][m][1][1]); w.w = pack2(acc[ai][bj][m][1][2], acc[ai][bj][m][1][3]);
            brs[(size_t)(s * 16 + (ai * 2 + bj) * 4 + m) * 512 + tid] = w;
          }
    } else {
      const int q = s - 4, bjq = q >> 1, nq = q & 1;
#pragma unroll
      for (int ai = 0; ai < 2; ++ai)
#pragma unroll
        for (int m = 0; m < 4; ++m) {
          float o[4] = {0.f, 0.f, 0.f, 0.f};
#pragma unroll
          for (int bj = 0; bj < 2; ++bj)
#pragma unroll
            for (int n = 0; n < 2; ++n) {
              const int ib = 2 * bj + n;
              const uint2 b2 = *(reinterpret_cast<const uint2*>(brs + (size_t)(ib * 16 + (ai * 2 + bjq) * 4 + m) * 512 + tid) + nq);
              const f32x4 g = acc[ai][bj][m][n];
              o[0] += sigm(g[0]) * lo2f(b2.x); o[1] += sigm(g[1]) * hi2f(b2.x);
              o[2] += sigm(g[2]) * lo2f(b2.y); o[3] += sigm(g[3]) * hi2f(b2.y);
            }
          const int r = u.pm * 256 + ai * 128 + wr * 64 + m * 16 + fr;
          const int d = dq * 256 + 64 * q + 16 * wc + 4 * fq;
          uint2 w; w.x = pack2(o[0], o[1]); w.y = pack2(o[2], o[3]);
          *reinterpret_cast<uint2*>(ACC + (size_t)r * 1024 + d) = w;
        }
    }
  }
};
__device__ __forceinline__ void phase_gm(const Params& p, int l, int Mrows, char* smem) {
  const u16* Wl = reinterpret_cast<const u16*>(p.ws + OFF_W) + (size_t)l * LAYER_W;
  SchedGM S;
  S.nM = Mrows / 256; S.nsuper = S.nM * 4; S.G = gridDim.x; S.c = blockIdx.x;
  S.Y = reinterpret_cast<const char*>(p.ws + OFF_Y);
  S.H = reinterpret_cast<const char*>(p.ws + OFF_H);
  S.Wb = reinterpret_cast<const char*>(Wl + WB_OFF);
  S.Wg = reinterpret_cast<const char*>(Wl + WG_OFF);
  EpiGM E;
  E.brs = reinterpret_cast<uint4*>(p.ws + OFF_BRS + (size_t)blockIdx.x * 524288);
  E.ACC = reinterpret_cast<u16*>(p.ws + OFF_ACC);
  gemm_phase((PG8_LAS unsigned char*)(smem), 1024, 1024, S, E);
}

__device__ __forceinline__ void phase_res(const Params& p, int l, int Mrows, const u16* A, int K, const u16* Bt, int gate_off, bool first, char* smem) {
  EpiRes E;
  E.xin_l = first ? p.in[0] : p.out;
  E.xin_c = first ? p.in[2] : reinterpret_cast<const float*>(p.ws + OFF_XC);
  E.xout_l = p.out;
  E.xout_c = reinterpret_cast<float*>(p.ws + OFF_XC);
  E.mod = reinterpret_cast<const float*>(p.ws + OFF_MOD) + (size_t)l * 33 * 6144;
  E.gate_off = gate_off;
  SchedStd S;
  S.init(Mrows / 256, 4, K, A, (size_t)256 * K * 2, Bt, (size_t)256 * K * 2);
  gemm_phase((PG8_LAS unsigned char*)(smem), K, K, S, E);
}

__device__ __forceinline__ void phase_ffn1(const Params& p, int l, int Mrows, char* smem) {
  const u16* H = reinterpret_cast<const u16*>(p.ws + OFF_H);
  const u16* W1T = reinterpret_cast<const u16*>(p.ws + OFF_W) + (size_t)l * LAYER_W + W1_OFF;
  EpiFfn1 E;
  E.HID = reinterpret_cast<u16*>(p.ws + OFF_HID);
  SchedStd S;
  S.init(Mrows / 256, 22, 1024, H, (size_t)256 * 1024 * 2, W1T, (size_t)256 * 1024 * 2);
  gemm_phase((PG8_LAS unsigned char*)(smem), 1024, 1024, S, E);
}

__device__ __forceinline__ void phase_final(const Params& p) {
  const int tid = tid_l();
  const int lane = tid & 63;
  const int gw = blockIdx.x * NW + (tid >> 6), tw = gridDim.x * NW;
  const float* nw = p.in[32];
  for (int r = gw; r < ML; r += tw) {
    float* xr = p.out + (size_t)r * 1024;
    float4 v[4];
    float ss = 0.f;
#pragma unroll
    for (int i = 0; i < 4; ++i) {
      v[i] = *reinterpret_cast<const float4*>(xr + i * 256 + lane * 4);
      ss += v[i].x * v[i].x + v[i].y * v[i].y + v[i].z * v[i].z + v[i].w * v[i].w;
    }
#pragma unroll
    for (int o = 32; o >= 1; o >>= 1) ss += __shfl_xor(ss, o);
    const float rs = rsqrtf(ss * (1.f / 1024.f) + EPS);
#pragma unroll
    for (int i = 0; i < 4; ++i) {
      const float4 g = *reinterpret_cast<const float4*>(nw + i * 256 + lane * 4);
      float4 o;
      o.x = v[i].x * rs * g.x; o.y = v[i].y * rs * g.y; o.z = v[i].z * rs * g.z; o.w = v[i].w * rs * g.w;
      *reinterpret_cast<float4*>(xr + i * 256 + lane * 4) = o;
    }
  }
}

__global__ void __launch_bounds__(NT, 2) mega(Params p) {
  cg::grid_group grid = cg::this_grid();
  extern __shared__ __attribute__((aligned(16))) unsigned char dsm[];
  char* smem = reinterpret_cast<char*>(dsm);
  volatile __attribute__((address_space(3))) unsigned* xst = (volatile __attribute__((address_space(3))) unsigned*)(dsm + SMALL_OFF + 16);
  if (threadIdx.x == 0) { xst[0] = 0u; xst[1] = 0u; }
  __syncthreads();
  const XcdBarrier xb = xcd_barrier_post(reinterpret_cast<unsigned*>(p.ws + OFF_BAR), xst);
  phase0(p, smem);
  grid.sync();
  mod_combine(p);
  xcd_barrier(xb);
  const u16* Wall = reinterpret_cast<const u16*>(p.ws + OFF_W);
#pragma unroll 1
  for (int l = 0; l < DEPTH; ++l) {
    const int Mpost = (l < DEPTH - 1) ? MT : ML;
    const u16* Wl = Wall + (size_t)l * LAYER_W;
    phase_norm(p, l, 0, MT);
    xcd_barrier(xb);
    phase_proj(p, l, smem);
    xcd_barrier(xb);
    phase_mix(p, l, smem);
    xcd_barrier(xb);
    phase_fin(p, l, Mpost, smem);
    xcd_barrier(xb);
    phase_gm(p, l, Mpost, smem);
    xcd_barrier(xb);
    phase_res(p, l, Mpost, reinterpret_cast<const u16*>(p.ws + OFF_ACC), 1024, Wl + WO_OFF, 2048, l == 0, smem);
    xcd_barrier(xb);
    phase_norm(p, l, 1, Mpost);
    xcd_barrier(xb);
    phase_ffn1(p, l, Mpost, smem);
    xcd_barrier(xb);
    phase_res(p, l, Mpost, reinterpret_cast<const u16*>(p.ws + OFF_HID), DFF, Wl + W2_OFF, 5120, false, smem);
    xcd_barrier(xb);
  }
  phase_final(p);
}

extern "C" void kernel_launch(void* const* d_in, const int* in_sizes, int n_in, void* d_out, int out_size,
                              void* d_ws, size_t ws_size, hipStream_t stream) {
  static int grid_blocks = 0;
  if (!grid_blocks) {
    int dev = 0, cus = 0, per_cu = 0;
    (void)hipGetDevice(&dev);
    (void)hipDeviceGetAttribute(&cus, hipDeviceAttributeMultiprocessorCount, dev);
    (void)hipFuncSetAttribute((const void*)mega, hipFuncAttributeMaxDynamicSharedMemorySize, DSM_BYTES);
    (void)hipOccupancyMaxActiveBlocksPerMultiprocessor(&per_cu, mega, NT, DSM_BYTES);
    if (per_cu < 1) per_cu = 1;
    if (per_cu > 1) per_cu = 1;
    grid_blocks = cus * per_cu;
    grid_blocks &= ~7;
    if (ws_size < WS_END) fprintf(stderr, "workspace too small: %zu < %zu\n", ws_size, (size_t)WS_END);
  }
  Params p{};
  for (int i = 0; i < 33; ++i) p.in[i] = (const float*)d_in[i];
  p.out = (float*)d_out;
  p.ws = (char*)d_ws;
  void* args[] = {&p};
  (void)hipMemsetAsync((char*)d_ws + OFF_CNT, 0, (OFF_BAR - OFF_CNT) + 3456 * 4, stream);
  hipError_t e = hipLaunchCooperativeKernel((void*)mega, dim3(grid_blocks), dim3(NT), args, DSM_BYTES, stream);
  if (e != hipSuccess) fprintf(stderr, "cooperative launch failed: %s (grid %d)\n", hipGetErrorString(e), grid_blocks);
}
```
